# Optimizing an MI355X kernel written in HIP

```python
import math
import jax, jax.numpy as jnp
from jax import lax
import numpy as np

D_MODEL = 1024
BATCH = 32
SEQ = 2048
DEPTH = 1

N_HEADS = 8
HEAD_DIM = 64
V_DIM = 2 * HEAD_DIM
ATTN_QK = N_HEADS * 2 * HEAD_DIM
ATTN_V = N_HEADS * V_DIM
Q_BLOCK = 128
POOL_WINDOWS = (2, 4, 8, 16)
N_POOL_GROUPS = len(POOL_WINDOWS)
POOL_GROUP_IN = 128
POOL_IN = N_POOL_GROUPS * POOL_GROUP_IN
POOL_GROUP_OUT = D_MODEL // N_POOL_GROUPS
N_BRANCHES = 2
IN_COLS = 2 * ATTN_QK + ATTN_V + POOL_IN + N_BRANCHES * D_MODEL
D_FF = -(-8 * D_MODEL // (3 * 256)) * 256
ALPHA = (2 * DEPTH) ** 0.25
BETA = (8 * DEPTH) ** -0.25
LN_EPS = 1e-5
RMS_EPS = 1e-5
N_MOD = 6

kernel_name = "hybrid_diffattn_multipool_deepnorm_block"


def alibi_slopes(n_heads):
    return np.array([2.0 ** (-8.0 * (h + 1) / n_heads) for h in range(n_heads)], dtype=np.float32)


def layer_norm(x, g=None, b=None):
    xf = x.astype(jnp.float32)
    mu = jnp.mean(xf, axis=-1, keepdims=True)
    var = jnp.mean(jnp.square(xf - mu), axis=-1, keepdims=True)
    y = (xf - mu) * lax.rsqrt(var + LN_EPS)
    if g is not None:
        y = y * g.astype(jnp.float32) + b.astype(jnp.float32)
    return y.astype(x.dtype)


def modulate(h, shift, scale):
    return h * (1.0 + scale[:, None, :]) + shift[:, None, :]


def diff_attention(q, k, v, lam, slopes, sub_g, lambda_init):
    B, S = q.shape[0], q.shape[1]
    nb = S // Q_BLOCK
    scale = HEAD_DIM ** -0.5
    kpos = jnp.arange(S)
    qb = q.reshape(B, nb, Q_BLOCK, N_HEADS, 2, HEAD_DIM).transpose(1, 0, 2, 3, 4, 5)

    def block(args):
        qblk, i = args
        qpos = i * Q_BLOCK + jnp.arange(Q_BLOCK)
        dist = jnp.abs(qpos[:, None] - kpos[None, :]).astype(jnp.float32)
        bias = -slopes[:, None, None] * dist[None]
        s = jnp.einsum('bqhmd,bkhmd->bhmqk', qblk, k,
                       preferred_element_type=jnp.float32) * scale + bias[None, :, None]
        p = jax.nn.softmax(s, axis=-1)
        a = p[:, :, 0] - lam * p[:, :, 1]
        return jnp.einsum('bhqk,bkhe->bqhe', a, v.astype(jnp.float32))

    o = lax.map(block, (qb, jnp.arange(nb)))
    o = o.transpose(1, 0, 2, 3, 4).reshape(B, S, N_HEADS, V_DIM)
    o = o * lax.rsqrt(jnp.mean(jnp.square(o), axis=-1, keepdims=True) + RMS_EPS)
    o = o * sub_g.astype(jnp.float32) * (1.0 - lambda_init)
    return o.reshape(B, S, ATTN_V).astype(q.dtype)


def multiscale_pool(u, w_pool, pool_scale):
    B, S = u.shape[0], u.shape[1]
    ug = u.astype(jnp.float32).reshape(B, S, N_POOL_GROUPS, POOL_GROUP_IN)
    csum = jnp.concatenate(
        [jnp.zeros((B, 1, N_POOL_GROUPS, POOL_GROUP_IN), jnp.float32), jnp.cumsum(ug, axis=1)], axis=1)
    t = jnp.arange(S)
    half = jnp.array([w // 2 for w in POOL_WINDOWS])
    lo = jnp.clip(t[:, None] - half[None, :], 0, S)
    hi = jnp.clip(t[:, None] + half[None, :], 0, S)
    g_idx = jnp.arange(N_POOL_GROUPS)[None, :]
    win_sum = csum[:, hi, g_idx] - csum[:, lo, g_idx]
    cnt = (hi - lo).astype(jnp.float32)[None, :, :, None]
    pooled = win_sum / cnt - ug
    y = jnp.einsum('bsgc,gce->bsge', pooled, w_pool.astype(jnp.float32))
    y = y.reshape(B, S, D_MODEL) * pool_scale.astype(jnp.float32)
    return y.astype(u.dtype)


def setup_inputs(seed: int = 0) -> dict:
    key = jax.random.key(seed)
    ks = jax.random.split(key, 20)
    n = jax.random.normal
    f32 = jnp.float32
    L, D = DEPTH, D_MODEL
    return {
        "x": n(ks[0], (BATCH, SEQ, D), f32),
        "c": n(ks[1], (BATCH, D), f32),
        "w_ada": n(ks[2], (L, D, N_MOD * D), f32) * (0.5 * D ** -0.5),
        "b_ada": n(ks[3], (L, N_MOD * D), f32) * 0.01,
        "w_in": n(ks[4], (L, D, IN_COLS), f32) * D ** -0.5,
        "lambda_q1": n(ks[5], (L, HEAD_DIM), f32) * 0.1,
        "lambda_k1": n(ks[6], (L, HEAD_DIM), f32) * 0.1,
        "lambda_q2": n(ks[7], (L, HEAD_DIM), f32) * 0.1,
        "lambda_k2": n(ks[8], (L, HEAD_DIM), f32) * 0.1,
        "sub_g": 1.0 + 0.02 * n(ks[9], (L, V_DIM), f32),
        "w_pool": n(ks[10], (L, N_POOL_GROUPS, POOL_GROUP_IN, POOL_GROUP_OUT), f32) * POOL_GROUP_IN ** -0.5,
        "pool_scale": 1.0 + 0.1 * n(ks[11], (L, D), f32),
        "w_out": n(ks[12], (L, D, D), f32) * (BETA * D ** -0.5),
        "ln1_g": 1.0 + 0.02 * n(ks[13], (L, D), f32),
        "ln1_b": 0.02 * n(ks[14], (L, D), f32),
        "w_ffn_in": n(ks[15], (L, D, 2 * D_FF), f32) * D ** -0.5,
        "w_ffn_out": n(ks[16], (L, D_FF, D), f32) * (BETA * D_FF ** -0.5),
        "ln2_g": 1.0 + 0.02 * n(ks[17], (L, D), f32),
        "ln2_b": 0.02 * n(ks[18], (L, D), f32),
    }


def reference(x, c, w_ada, b_ada, w_in, lambda_q1, lambda_k1, lambda_q2, lambda_k2, sub_g,
              w_pool, pool_scale, w_out, ln1_g, ln1_b, w_ffn_in, w_ffn_out, ln2_g, ln2_b):
    B, S, D = x.shape
    slopes = jnp.asarray(alibi_slopes(N_HEADS))
    c_act = jax.nn.silu(c)
    for l in range(DEPTH):
        lambda_init = 0.8 - 0.6 * math.exp(-0.3 * l)
        mod = c_act @ w_ada[l] + b_ada[l]
        sh1, sc1, g1, sh2, sc2, g2 = jnp.split(mod, N_MOD, axis=-1)

        h = modulate(layer_norm(x), sh1, sc1)
        proj = h @ w_in[l]
        q, k, v, u, gates = jnp.split(
            proj, np.cumsum([ATTN_QK, ATTN_QK, ATTN_V, POOL_IN]).tolist(), axis=-1)
        q = q.reshape(B, S, N_HEADS, 2, HEAD_DIM)
        k = k.reshape(B, S, N_HEADS, 2, HEAD_DIM)
        v = v.reshape(B, S, N_HEADS, V_DIM)
        lam = (jnp.exp(jnp.sum(lambda_q1[l].astype(jnp.float32) * lambda_k1[l].astype(jnp.float32)))
               - jnp.exp(jnp.sum(lambda_q2[l].astype(jnp.float32) * lambda_k2[l].astype(jnp.float32)))
               + lambda_init)
        a_out = diff_attention(q, k, v, lam, slopes, sub_g[l], lambda_init)
        p_out = multiscale_pool(u, w_pool[l], pool_scale[l])
        ga, gp = jnp.split(gates, N_BRANCHES, axis=-1)
        mixed = jax.nn.sigmoid(ga) * a_out + jax.nn.sigmoid(gp) * p_out
        y = mixed @ w_out[l]
        x = layer_norm(ALPHA * x + g1[:, None, :] * y, ln1_g[l], ln1_b[l])

        h = modulate(layer_norm(x), sh2, sc2)
        gt, up = jnp.split(h @ w_ffn_in[l], 2, axis=-1)
        y = (jax.nn.silu(gt) * up) @ w_ffn_out[l]
        x = layer_norm(ALPHA * x + g2[:, None, :] * y, ln2_g[l], ln2_b[l])
    return x
```

```cpp
#include <hip/hip_runtime.h>
#include <hip/hip_cooperative_groups.h>
#include <cstdio>
#include <cstdint>
namespace cg = cooperative_groups;

constexpr int D = 1024, BATCH = 32, SEQ = 2048, MROWS = BATCH * SEQ, NH = 8, INC = 5632, DFF = 2816, PIN = 512, NMOD = 6144;
constexpr float ALPHA = 1.189207115002721f;
constexpr float LN_EPS = 1e-5f, RMS_EPS = 1e-5f;
constexpr float LOG2E = 1.4426950408889634f;
constexpr float QSCALE = 0.125f * LOG2E;

#ifndef HEADMAJOR
#define HEADMAJOR 1
#endif
namespace pg8 {
#define PG8_LAS __attribute__((address_space(3)))
typedef unsigned short bf16_t;
typedef short bf16x8 __attribute__((ext_vector_type(8)));
typedef float f32x4 __attribute__((ext_vector_type(4)));
typedef unsigned u32x4 __attribute__((ext_vector_type(4)));
constexpr int BM = 256, BK = 64, HALF = 128, HTB = HALF * BK * 2  , STAGE_BYTES = 8 * HTB, NXCD = 8, WGM = 8;

__host__ __device__ __forceinline__ int lds_byte(int r, int c) { const int st = (r >> 4) * 2 + (c >> 5), rr = r & 15, cc = c & 31, ob = rr * 64 + cc * 2; return st * 1024 + (ob ^ (((ob >> 9) & 1) << 5)); }
__host__ __device__ __forceinline__ void stage_rc(int b, int& R, int& C) { const int st = b / 1024, sb = b % 1024, swz = sb ^ (((sb >> 9) & 1) << 5); R = (st >> 1) * 16 + swz / 64; C = (st & 1) * 32 + (swz % 64) / 2; }
__host__ __device__ __forceinline__ int perm32(int rho) { const int n = rho >> 4, i = rho & 15; return 8 * (i >> 2) + 4 * n + (i & 3); }

struct Unit { int pm, pn; };
struct Gemm { const bf16_t* A; const bf16_t* Bt; int M, N, K, lda, ldb, apn; };

struct StaticOrder {
    int nM, nN, nwg, G, c;
    __host__ __device__ void init(int M, int N, int G_, int c_) { nM = M / BM; nN = N / BM; nwg = nM * nN; G = G_; c = c_; }
    __host__ __device__ bool next(int i, Unit& u) const {
        const long L = (long)i * G + c; if (L >= nwg) return false;
        int wgid = (int)L; { const int q = nwg / NXCD, r = nwg % NXCD, xcd = wgid % NXCD, off = wgid / NXCD; wgid = (xcd < r ? xcd * (q + 1) : r * (q + 1) + (xcd - r) * q) + off; }
        const int nig = WGM * nN, gid = wgid / nig, fm = gid * WGM, gsz = (nM - fm) < WGM ? (nM - fm) : WGM;
        u.pm = fm + ((wgid % nig) % gsz); u.pn = (wgid % nig) / gsz; return true;
    }
    __device__ __forceinline__ void a_ready(const Unit&) const {}
    __device__ __forceinline__ void done(const Unit&) const {}
};


__device__ __forceinline__ unsigned cvt_pk_bf16(float lo, float hi) { unsigned r; asm volatile("v_cvt_pk_bf16_f32 %0, %1, %2" : "=v"(r) : "v"(lo), "v"(hi)); return r; }
__device__ __forceinline__ float bf_lo(unsigned w) { return __uint_as_float(w << 16); }
__device__ __forceinline__ float bf_hi(unsigned w) { return __uint_as_float(w & 0xffff0000u); }
__device__ __forceinline__ float sigm(float x) { return __builtin_amdgcn_rcpf(1.0f + __builtin_amdgcn_exp2f(-1.4426950408889634f * x)); }

struct EpiProj {
    static constexpr bool PERM = true, AFTER_DRAIN = false;
    bf16_t *Q, *Kb, *V, *U, *G; float qscale; unsigned* nrmk;
    __device__ __forceinline__ void operator()(const f32x4 (&acc)[2][2][4][2], const Unit& u, int wr, int wc, int fr, int fq) const {
        const int pn = u.pn;
        if (pn >= 4 && pn < 8) {
            const int lane = fq * 16 + fr;
#pragma unroll
            for (int bj = 0; bj < 2; ++bj) { float mx = 0.f;
#pragma unroll
                for (int ai = 0; ai < 2; ++ai)
#pragma unroll
                    for (int m = 0; m < 4; ++m) { const f32x4 a = acc[ai][bj][m][0], c = acc[ai][bj][m][1];
                        float s = (a[0] * a[0] + a[1] * a[1]) + (a[2] * a[2] + a[3] * a[3]) + (c[0] * c[0] + c[1] * c[1]) + (c[2] * c[2] + c[3] * c[3]);
                        s += __builtin_bit_cast(float, __builtin_amdgcn_ds_bpermute((lane ^ 16) << 2, __builtin_bit_cast(int, s)));
                        s += __builtin_bit_cast(float, __builtin_amdgcn_ds_bpermute((lane ^ 32) << 2, __builtin_bit_cast(int, s)));
                        mx = fmaxf(mx, s); }
#pragma unroll
                for (int x = 1; x < 16; x <<= 1) mx = fmaxf(mx, __builtin_bit_cast(float, __builtin_amdgcn_ds_bpermute((lane ^ x) << 2, __builtin_bit_cast(int, mx))));
                if (lane == 0) atomicMax(nrmk + (((u.pm >> 3) * 8 + 2 * (pn - 4) + bj) * 2 + (wc >> 1)) * 2 + (wc & 1), __float_as_uint(mx)); }
        }
        if (HEADMAJOR && pn < 12) {
            bf16_t* base; int ct; float sc = 1.f;
            if (pn < 4) { base = Q; ct = pn; sc = qscale; } else if (pn < 8) { base = Kb; ct = pn - 4; } else { base = V; ct = pn - 8; }
            const int b = u.pm >> 3, t0 = (u.pm & 7) * BM + wr * 64 + fr;
#pragma unroll
            for (int bj = 0; bj < 2; ++bj) { bf16_t* hb = base + ((size_t)((b * 8 + 2 * ct + bj) * 2048 + t0)) * 128 + wc * 32 + 8 * fq;
#pragma unroll
                for (int ai = 0; ai < 2; ++ai)
#pragma unroll
                    for (int m = 0; m < 4; ++m) { const f32x4 v0 = acc[ai][bj][m][0] * sc, v1 = acc[ai][bj][m][1] * sc;
                        u32x4 w; w.x = cvt_pk_bf16(v0[0], v0[1]); w.y = cvt_pk_bf16(v0[2], v0[3]); w.z = cvt_pk_bf16(v1[0], v1[1]); w.w = cvt_pk_bf16(v1[2], v1[3]);
                        __builtin_nontemporal_store(w, (u32x4*)(hb + (ai * HALF + m * 16) * 128)); } }
        } else {
            bf16_t* base; int ld, ct; float sc = 1.f;
            if (pn < 4) { base = Q; ld = 1024; ct = pn; sc = qscale; } else if (pn < 8) { base = Kb; ld = 1024; ct = pn - 4; } else if (pn < 12) { base = V; ld = 1024; ct = pn - 8; }
            else if (pn < 14) { base = U; ld = 512; ct = pn - 12; } else { base = G; ld = 2048; ct = pn - 14; }
            const int row0 = u.pm * BM + wr * 64 + fr, col0 = ct * 256 + wc * 32 + 8 * fq;
#pragma unroll
            for (int ai = 0; ai < 2; ++ai)
#pragma unroll
                for (int m = 0; m < 4; ++m) { bf16_t* rowp = base + (size_t)(row0 + ai * HALF + m * 16) * ld + col0;
#pragma unroll
                    for (int bj = 0; bj < 2; ++bj) { const f32x4 v0 = acc[ai][bj][m][0] * sc, v1 = acc[ai][bj][m][1] * sc;
                        u32x4 w; w.x = cvt_pk_bf16(v0[0], v0[1]); w.y = cvt_pk_bf16(v0[2], v0[3]); w.z = cvt_pk_bf16(v1[0], v1[1]); w.w = cvt_pk_bf16(v1[2], v1[3]);
                        __builtin_nontemporal_store(w, (u32x4*)(rowp + bj * HALF)); } }
        }
    }
};
struct EpiGate {
    static constexpr bool PERM = true, AFTER_DRAIN = false;
    bf16_t* out; const float* gate;
    __device__ __forceinline__ void operator()(const f32x4 (&acc)[2][2][4][2], const Unit& u, int wr, int wc, int fr, int fq) const {
        const int row0 = u.pm * BM + wr * 64 + fr, col0 = u.pn * 256 + wc * 32 + 8 * fq;
        const float* gp = gate + (size_t)(u.pm >> 3) * 6144 + col0;
        f32x4 gq[2][2];
#pragma unroll
        for (int bj = 0; bj < 2; ++bj) { gq[bj][0] = *(const f32x4*)(gp + bj * HALF); gq[bj][1] = *(const f32x4*)(gp + bj * HALF + 4); }
#pragma unroll
        for (int bj = 0; bj < 2; ++bj) { const f32x4 g0 = gq[bj][0], g1 = gq[bj][1];
#pragma unroll
            for (int ai = 0; ai < 2; ++ai)
#pragma unroll
                for (int m = 0; m < 4; ++m) { const f32x4 v0 = acc[ai][bj][m][0] * g0, v1 = acc[ai][bj][m][1] * g1;
                    u32x4 w; w.x = cvt_pk_bf16(v0[0], v0[1]); w.y = cvt_pk_bf16(v0[2], v0[3]); w.z = cvt_pk_bf16(v1[0], v1[1]); w.w = cvt_pk_bf16(v1[2], v1[3]);
                    *(u32x4*)(out + (size_t)(row0 + ai * HALF + m * 16) * 1024 + col0 + bj * HALF) = w; } }
    }
};
struct EpiSwiglu {
    static constexpr bool PERM = true, AFTER_DRAIN = false;
    bf16_t* out;
    __device__ __forceinline__ void operator()(const f32x4 (&acc)[2][2][4][2], const Unit& u, int wr, int wc, int fr, int fq) const {
        const int row0 = u.pm * BM + wr * 64 + fr, col0 = u.pn * 128 + wc * 32 + 8 * fq;
#pragma unroll
        for (int ai = 0; ai < 2; ++ai)
#pragma unroll
            for (int m = 0; m < 4; ++m) { bf16_t* rowp = out + (size_t)(row0 + ai * HALF + m * 16) * 2816 + col0;
                const f32x4 g0 = acc[ai][0][m][0], g1 = acc[ai][0][m][1], u0 = acc[ai][1][m][0], u1 = acc[ai][1][m][1];
                u32x4 w;
                w.x = cvt_pk_bf16(g0[0] * sigm(g0[0]) * u0[0], g0[1] * sigm(g0[1]) * u0[1]);
                w.y = cvt_pk_bf16(g0[2] * sigm(g0[2]) * u0[2], g0[3] * sigm(g0[3]) * u0[3]);
                w.z = cvt_pk_bf16(g1[0] * sigm(g1[0]) * u1[0], g1[1] * sigm(g1[1]) * u1[1]);
                w.w = cvt_pk_bf16(g1[2] * sigm(g1[2]) * u1[2], g1[3] * sigm(g1[3]) * u1[3]);
                __builtin_nontemporal_store(w, (u32x4*)rowp); }
    }
};

template <class Epi, class Sched, bool ALIGN_EPI = false, bool SP2 = false>
__device__ __forceinline__ void gemm_phase(PG8_LAS unsigned char* lds, const Gemm g, const Sched& S, const Epi& E) {
    int tid_ = threadIdx.x; asm volatile("" : "+v"(tid_));
    const int tid = tid_, wid = __builtin_amdgcn_readfirstlane(tid >> 6), lane = tid & 63, wr = wid >> 2, wc = wid & 3, fr = lane & 15, fq = lane >> 4;
    const int K = g.K, nt = K / BK;
    unsigned voffA[2], voffB[2];
#pragma unroll
    for (int i = 0; i < 2; ++i) { int R, C; stage_rc(tid * 16 + i * 8192, R, C); const int Rb = Epi::PERM ? ((R & ~31) + perm32(R & 31)) : R;
        voffA[i] = (unsigned)(R * g.lda + C) * 2u; voffB[i] = (unsigned)(Rb * g.ldb + C) * 2u; }
    const size_t kstep = (size_t)(BK * 2);
    const size_t hstepA = (size_t)HALF * g.lda * 2, hstepB = (size_t)HALF * g.ldb * 2;
    const size_t tstepA = 2 * hstepA, tstepB = 2 * hstepB, apn = (size_t)g.apn;
    const unsigned ldsw = (unsigned)wid * 1024u;
    const int aoff = lds_byte(wr * 64 + fr, fq * 8), boff = lds_byte(wc * 32 + fr, fq * 8);
#define PG8_SA(b, h) (((b) * 2 + (h)) * HTB)
#define PG8_SB(b, h) ((4 + (b) * 2 + (h)) * HTB)
#define PG8_STAGE(bufoff, gbase, voff) do { _Pragma("unroll") for (int _i = 0; _i < 2; ++_i) \
        __builtin_amdgcn_global_load_lds((const unsigned*)((const char*)(gbase) + (voff)[_i]), (PG8_LAS unsigned*)(lds + (bufoff) + ldsw + _i * 8192), 16, 0, 0); } while (0)
#define PG8_LDA(dst, b, h) do { _Pragma("unroll") for (int m = 0; m < 4; ++m) _Pragma("unroll") for (int k = 0; k < 2; ++k) dst[m][k] = *(const PG8_LAS bf16x8*)(lds + PG8_SA(b, h) + aoff + m * 2048 + k * 1024); } while (0)
#define PG8_LDB(dst, b, h) do { _Pragma("unroll") for (int n = 0; n < 2; ++n) _Pragma("unroll") for (int k = 0; k < 2; ++k) dst[n][k] = *(const PG8_LAS bf16x8*)(lds + PG8_SB(b, h) + boff + n * 2048 + k * 1024); } while (0)
#define PG8_MMA(ai, bj, At, Bt) do { __builtin_amdgcn_s_setprio(1); _Pragma("unroll") for (int m = 0; m < 4; ++m) _Pragma("unroll") for (int n = 0; n < 2; ++n) _Pragma("unroll") for (int k = 0; k < 2; ++k) \
        acc[ai][bj][m][n] = __builtin_amdgcn_mfma_f32_16x16x32_bf16(Bt[n][k], At[m][k], acc[ai][bj][m][n], 0, 0, 0); __builtin_amdgcn_s_setprio(0); } while (0)
#define PG8_WAIT_V(n) asm volatile("s_waitcnt vmcnt(" #n ")" ::: "memory")
#define PG8_WAIT_L(n) asm volatile("s_waitcnt lgkmcnt(" #n ")" ::: "memory")
#define PG8_BAR __builtin_amdgcn_s_barrier()
#define PG8_SCHED __builtin_amdgcn_sched_barrier(0)
    Unit cur, nxt; int ui = 0;
    if (!S.next(0, cur)) return;
    f32x4 acc[2][2][4][2];
#pragma unroll
    for (int a = 0; a < 2; ++a)
#pragma unroll
        for (int b = 0; b < 2; ++b)
#pragma unroll
            for (int m = 0; m < 4; ++m)
#pragma unroll
                for (int n = 0; n < 2; ++n) acc[a][b][m][n] = (f32x4){0.f, 0.f, 0.f, 0.f};
    bf16x8 At[4][2], B0[2][2], B1[2][2];
    const char* cA = (const char*)g.A + (size_t)cur.pm * tstepA + (size_t)cur.pn * apn; const char* cB = (const char*)g.Bt + (size_t)cur.pn * tstepB;
    S.a_ready(cur);
    if constexpr (SP2) {
        PG8_STAGE(PG8_SB(0, 0), cB, voffB); PG8_STAGE(PG8_SB(0, 1), cB + hstepB, voffB); PG8_STAGE(PG8_SA(0, 0), cA, voffA); PG8_STAGE(PG8_SA(0, 1), cA + hstepA, voffA);
        if (wr == 1) PG8_BAR;
        PG8_WAIT_V(2); PG8_BAR;
        PG8_STAGE(PG8_SB(1, 0), cB + kstep, voffB); PG8_STAGE(PG8_SA(1, 0), cA + kstep, voffA); PG8_STAGE(PG8_SB(1, 1), cB + hstepB + kstep, voffB);
        PG8_WAIT_V(6); PG8_BAR;
    } else {
        PG8_STAGE(PG8_SB(0, 0), cB, voffB); PG8_STAGE(PG8_SA(0, 0), cA, voffA); PG8_STAGE(PG8_SB(0, 1), cB + hstepB, voffB); PG8_STAGE(PG8_SA(0, 1), cA + hstepA, voffA);
        if (wr == 1) PG8_BAR;
        PG8_WAIT_V(4); PG8_BAR;
        PG8_STAGE(PG8_SB(1, 0), cB + kstep, voffB); PG8_STAGE(PG8_SA(1, 0), cA + kstep, voffA); PG8_STAGE(PG8_SB(1, 1), cB + hstepB + kstep, voffB);
        PG8_WAIT_V(6); PG8_BAR;
    }
    for (;;) {
        const bool has_next = S.next(ui + 1, nxt);
        const char* nA = has_next ? (const char*)g.A + (size_t)nxt.pm * tstepA + (size_t)nxt.pn * apn : cA; const char* nB = has_next ? (const char*)g.Bt + (size_t)nxt.pn * tstepB : cB;
        for (int t = 0; t < nt; t += 2) {
            const bool last = (t == nt - 2);
            const char* a1 = cA + (size_t)(t + 1) * kstep;
            const char* a2 = last ? nA : cA + (size_t)(t + 2) * kstep; const char* b2 = last ? nB : cB + (size_t)(t + 2) * kstep;
            const char* a3 = a2 + kstep; const char* b3 = b2 + kstep;
            if (last && has_next) S.a_ready(nxt);
            if constexpr (SP2) {
            PG8_LDB(B0, 0, 0); PG8_LDB(B1, 0, 1); PG8_SCHED; PG8_LDA(At, 0, 0); PG8_STAGE(PG8_SA(1, 1), a1 + hstepA, voffA);
            PG8_WAIT_V(8); PG8_WAIT_L(0); PG8_BAR; PG8_MMA(0, 0, At, B0); PG8_MMA(0, 1, At, B1); PG8_BAR; PG8_SCHED;
            PG8_LDA(At, 0, 1); PG8_STAGE(PG8_SB(0, 0), b2, voffB); PG8_STAGE(PG8_SB(0, 1), b2 + hstepB, voffB); PG8_STAGE(PG8_SA(0, 0), a2, voffA);
            PG8_WAIT_V(8); PG8_WAIT_L(0); PG8_BAR; PG8_MMA(1, 0, At, B0); PG8_MMA(1, 1, At, B1); PG8_BAR; PG8_SCHED;
            PG8_LDB(B0, 1, 0); PG8_LDB(B1, 1, 1); PG8_SCHED; PG8_LDA(At, 1, 0); PG8_STAGE(PG8_SA(0, 1), a2 + hstepA, voffA);
            PG8_WAIT_V(8); PG8_WAIT_L(0); PG8_BAR; PG8_MMA(0, 0, At, B0); PG8_MMA(0, 1, At, B1); PG8_BAR; PG8_SCHED;
            PG8_LDA(At, 1, 1); PG8_STAGE(PG8_SB(1, 0), b3, voffB); PG8_STAGE(PG8_SB(1, 1), b3 + hstepB, voffB); PG8_STAGE(PG8_SA(1, 0), a3, voffA);
            PG8_WAIT_V(8); PG8_WAIT_L(0); PG8_BAR; PG8_MMA(1, 0, At, B0); PG8_MMA(1, 1, At, B1); PG8_BAR; PG8_SCHED;
            } else {
            PG8_LDB(B0, 0, 0); PG8_SCHED; PG8_LDA(At, 0, 0); PG8_STAGE(PG8_SA(1, 1), a1 + hstepA, voffA);
            PG8_WAIT_L(8); PG8_BAR; PG8_WAIT_L(0); PG8_MMA(0, 0, At, B0); PG8_BAR; PG8_SCHED;
            PG8_LDB(B1, 0, 1); PG8_STAGE(PG8_SB(0, 0), b2, voffB);
            PG8_BAR; PG8_WAIT_L(0); PG8_MMA(0, 1, At, B1); PG8_BAR;
            PG8_LDA(At, 0, 1); PG8_STAGE(PG8_SA(0, 0), a2, voffA);
            PG8_BAR; PG8_WAIT_L(0); PG8_MMA(1, 0, At, B0); PG8_BAR; PG8_SCHED;
            PG8_STAGE(PG8_SB(0, 1), b2 + hstepB, voffB);
            PG8_WAIT_V(6); PG8_BAR; PG8_MMA(1, 1, At, B1); PG8_BAR;
            PG8_LDB(B0, 1, 0); PG8_SCHED; PG8_LDA(At, 1, 0); PG8_STAGE(PG8_SA(0, 1), a2 + hstepA, voffA);
            PG8_WAIT_L(8); PG8_BAR; PG8_WAIT_L(0); PG8_MMA(0, 0, At, B0); PG8_BAR; PG8_SCHED;
            PG8_LDB(B1, 1, 1); PG8_STAGE(PG8_SB(1, 0), b3, voffB);
            PG8_BAR; PG8_WAIT_L(0); PG8_MMA(0, 1, At, B1); PG8_BAR;
            PG8_LDA(At, 1, 1); PG8_STAGE(PG8_SA(1, 0), a3, voffA);
            PG8_BAR; PG8_WAIT_L(0); PG8_MMA(1, 0, At, B0); PG8_BAR; PG8_SCHED;
            PG8_STAGE(PG8_SB(1, 1), b3 + hstepB, voffB);
            PG8_WAIT_V(6); PG8_BAR; PG8_MMA(1, 1, At, B1); PG8_BAR;
            }
        }
        if constexpr (ALIGN_EPI) { if (wr == 0) PG8_BAR; }
        if constexpr (!Epi::AFTER_DRAIN) { E(acc, cur, wr, wc, fr, fq); S.done(cur); }
        if (!has_next) break;
#pragma unroll
        for (int a = 0; a < 2; ++a)
#pragma unroll
            for (int b = 0; b < 2; ++b)
#pragma unroll
                for (int m = 0; m < 4; ++m)
#pragma unroll
                    for (int n = 0; n < 2; ++n) acc[a][b][m][n] = (f32x4){0.f, 0.f, 0.f, 0.f};
        cur = nxt; cA = nA; cB = nB; ++ui;
        if constexpr (ALIGN_EPI) { if (wr == 1) PG8_BAR; }
    }
    PG8_WAIT_V(0);
    if constexpr (!ALIGN_EPI) { if (wr == 0) PG8_BAR; }
    PG8_BAR;
    if constexpr (Epi::AFTER_DRAIN) { E.fused(acc, cur, wr, wc, fr, fq, lds, wid, lane); S.done(cur); }
#undef PG8_SA
#undef PG8_SB
#undef PG8_STAGE
#undef PG8_LDA
#undef PG8_LDB
#undef PG8_MMA
#undef PG8_WAIT_V
#undef PG8_WAIT_L
#undef PG8_BAR
#undef PG8_SCHED
}
}

namespace attn {
typedef unsigned short bf16_t;
using bf16x8 = __attribute__((ext_vector_type(8))) short;
using s16x4  = __attribute__((ext_vector_type(4))) short;
using f32x16 = __attribute__((ext_vector_type(16))) float;
using u32x4  = __attribute__((ext_vector_type(4))) unsigned;
constexpr int NW = 8, QBLK = 32, KVBLK = 64, LD = HEADMAJOR ? 128 : 1024;
constexpr size_t SHM_V = KVBLK * 128 * 2, SHM_K = KVBLK * 128 * 2, SHM_ATTN = 2 * SHM_V + 2 * SHM_K + NW * 64 * 4;
#ifndef ATT_REP
#define ATT_REP 1
#endif
constexpr float TSKIP = 40.f;
constexpr float THRL = 11.5f;
#define KSWZ(row, colB) ((row) * 256 + ((colB) ^ (((row) & 7) << 4)))
#define SBAR() __builtin_amdgcn_sched_barrier(0)
__device__ __forceinline__ int crow(int r, int hi) { return (r & 3) + 8 * (r >> 2) + 4 * hi; }
__device__ __forceinline__ unsigned cvtpk(float lo, float hi) { unsigned r; asm volatile("v_cvt_pk_bf16_f32 %0, %1, %2" : "=v"(r) : "v"(lo), "v"(hi)); return r; }
__device__ __forceinline__ bf16x8 ld8(const bf16_t* p) { return *reinterpret_cast<const bf16x8*>(p); }

__device__ __forceinline__ int v_st(int k, int c) { const int kk = (k & ~0xC) | ((k & 4) << 1) | ((k & 8) >> 1); return ((kk >> 3) * 4 + (c >> 5)) * 512 + ((kk & 7) * 32 + (c & 31)) * 2; }
__device__ __forceinline__ int v_rd_base(int lane) { return ((lane & 3) << 3) | (((lane >> 2) & 3) << 6) | (((lane >> 4) & 1) << 5) | (((lane >> 5) & 1) << 8); }
constexpr int v_rd_off(int d0, int ks, int half) { return d0 * 512 + ks * 4096 + half * 2048; }
template <int OFF> __device__ __forceinline__ s16x4 tr_read(int vb) {
  s16x4 r; asm volatile("ds_read_b64_tr_b16 %0, %1 offset:%2" : "=&v"(r) : "v"(vb), "i"(OFF) : "memory"); return r;
}
template <int D0> __device__ __forceinline__ void pv_one(f32x16& od, int vb, bf16x8 pa0, bf16x8 pa1, bf16x8 pa2, bf16x8 pa3) {
  const s16x4 l0 = tr_read<v_rd_off(D0, 0, 0)>(vb), h0 = tr_read<v_rd_off(D0, 0, 1)>(vb), l1 = tr_read<v_rd_off(D0, 1, 0)>(vb), h1 = tr_read<v_rd_off(D0, 1, 1)>(vb);
  const s16x4 l2 = tr_read<v_rd_off(D0, 2, 0)>(vb), h2 = tr_read<v_rd_off(D0, 2, 1)>(vb), l3 = tr_read<v_rd_off(D0, 3, 0)>(vb), h3 = tr_read<v_rd_off(D0, 3, 1)>(vb);
  asm volatile("s_waitcnt lgkmcnt(0)" ::: "memory"); SBAR();
#define PK(L, H) (bf16x8){L[0], L[1], L[2], L[3], H[0], H[1], H[2], H[3]}
  od = __builtin_amdgcn_mfma_f32_32x32x16_bf16(pa0, PK(l0, h0), od, 0, 0, 0);
  od = __builtin_amdgcn_mfma_f32_32x32x16_bf16(pa1, PK(l1, h1), od, 0, 0, 0);
  od = __builtin_amdgcn_mfma_f32_32x32x16_bf16(pa2, PK(l2, h2), od, 0, 0, 0);
  od = __builtin_amdgcn_mfma_f32_32x32x16_bf16(pa3, PK(l3, h3), od, 0, 0, 0);
#undef PK
}
__device__ __forceinline__ void pv_d0(f32x16* o, int vb, bf16x8 pa0, bf16x8 pa1, bf16x8 pa2, bf16x8 pa3) {
  pv_one<0>(o[0], vb, pa0, pa1, pa2, pa3); pv_one<1>(o[1], vb, pa0, pa1, pa2, pa3); pv_one<2>(o[2], vb, pa0, pa1, pa2, pa3); pv_one<3>(o[3], vb, pa0, pa1, pa2, pa3);
}

constexpr size_t SHM_X = 2 * SHM_V + 2 * SHM_K + NW * 64 * 4;
constexpr size_t SHM_ATTN_PP = SHM_X + 4 * 64 * 64 * 4;
__device__ __forceinline__ void qkt_c(f32x16& p0, f32x16& p1, const char* Ks, const bf16x8* qr, const f32x16& negm, int r32, int hi) {
#pragma unroll
  for (int d0 = 0; d0 < 4; ++d0) { const int cb = (d0 * 16 + hi * 8) * 2;
    bf16x8 b0 = *reinterpret_cast<const bf16x8*>(Ks + KSWZ(r32, cb));
    bf16x8 b1 = *reinterpret_cast<const bf16x8*>(Ks + KSWZ(32 + r32, cb));
    if (d0 == 0) { p0 = __builtin_amdgcn_mfma_f32_32x32x16_bf16(b0, qr[0], negm, 0, 0, 0); p1 = __builtin_amdgcn_mfma_f32_32x32x16_bf16(b1, qr[0], negm, 0, 0, 0); }
    else { p0 = __builtin_amdgcn_mfma_f32_32x32x16_bf16(b0, qr[d0], p0, 0, 0, 0); p1 = __builtin_amdgcn_mfma_f32_32x32x16_bf16(b1, qr[d0], p1, 0, 0, 0); } }
}
template <int R> __device__ __forceinline__ void bias_r(f32x16& p0, f32x16& p1, float dq, float nslope) {
  constexpr int C0 = (R & 3) + 8 * (R >> 2);
  float x0, x1, a0 = p0[R], a1 = p1[R];
  asm("v_sub_f32_e32 %0, %1, %2" : "=v"(x0) : "n"(__builtin_bit_cast(int, (float)C0)), "v"(dq));
  asm("v_sub_f32_e32 %0, %1, %2" : "=v"(x1) : "n"(__builtin_bit_cast(int, (float)(C0 + 32))), "v"(dq));
  asm("v_fma_f32 %0, %1, |%2|, %0" : "+v"(a0) : "v"(nslope), "v"(x0));
  asm("v_fma_f32 %0, %1, |%2|, %0" : "+v"(a1) : "v"(nslope), "v"(x1));
  p0[R] = a0; p1[R] = a1;
  if constexpr (R < 15) bias_r<R + 1>(p0, p1, dq, nslope);
}
__device__ __forceinline__ bool softmax_pp(f32x16& p0, f32x16& p1, float& m_reg, float& l_reg, f32x16& negm, float& alpha, float& m_run, float dq, float nslope,
                                           bf16x8& pa0, bf16x8& pa1, bf16x8& pa2, bf16x8& pa3) {
  bias_r<0>(p0, p1, dq, nslope);
  float a = fmaxf(fmaxf(p0[0], p0[1]), p1[0]), bq = fmaxf(fmaxf(p0[2], p0[3]), p1[1]); a = fmaxf(fmaxf(a, p1[2]), p1[3]);
#pragma unroll
  for (int r = 4; r < 16; r += 4) { a = fmaxf(fmaxf(a, p0[r]), p0[r + 1]); bq = fmaxf(fmaxf(bq, p0[r + 2]), p0[r + 3]); a = fmaxf(fmaxf(a, p1[r]), p1[r + 1]); bq = fmaxf(fmaxf(bq, p1[r + 2]), p1[r + 3]); }
  float pmax = fmaxf(a, bq);
  { auto rr = __builtin_amdgcn_permlane32_swap(__float_as_uint(pmax), __float_as_uint(pmax), false, false);
    pmax = fmaxf(__uint_as_float(rr[0]), __uint_as_float(rr[1])); }
  alpha = 1.f;
  { const float tmax = pmax + m_reg;
    if (__all(tmax < m_run - TSKIP)) return false;
    m_run = fmaxf(m_run, tmax); }
  if (__builtin_expect(!__all(pmax <= THRL), 0)) { const float dl = fmaxf(pmax, 0.f); m_reg += dl; alpha = __builtin_amdgcn_exp2f(-dl);
#pragma unroll
    for (int r = 0; r < 16; ++r) { p0[r] -= dl; p1[r] -= dl; }
#pragma unroll
    for (int r = 0; r < 16; ++r) negm[r] = -m_reg; }
#pragma unroll
  for (int r = 0; r < 16; ++r) { p0[r] = __builtin_amdgcn_exp2f(p0[r]); p1[r] = __builtin_amdgcn_exp2f(p1[r]); }
  float ps = 0;
#pragma unroll
  for (int r = 0; r < 16; ++r) ps += p0[r];
#pragma unroll
  for (int r = 0; r < 16; ++r) ps += p1[r];
  { auto rr = __builtin_amdgcn_permlane32_swap(__float_as_uint(ps), __float_as_uint(ps), false, false);
    ps = __uint_as_float(rr[0]) + __uint_as_float(rr[1]); }
  l_reg = l_reg * alpha + ps;
#define PK4(P, BASE, OUT) do { unsigned a0 = cvtpk(P[BASE + 0], P[BASE + 1]), a1 = cvtpk(P[BASE + 2], P[BASE + 3]);   \
    unsigned b0 = cvtpk(P[BASE + 4], P[BASE + 5]), b1 = cvtpk(P[BASE + 6], P[BASE + 7]);                              \
    auto r0 = __builtin_amdgcn_permlane32_swap(a0, b0, false, false); auto r1 = __builtin_amdgcn_permlane32_swap(a1, b1, false, false); \
    u32x4 w = {r0[0], r1[0], r0[1], r1[1]}; OUT = *reinterpret_cast<bf16x8*>(&w); } while (0)
  PK4(p0, 0, pa0); PK4(p0, 8, pa1); PK4(p1, 0, pa2); PK4(p1, 8, pa3);
#undef PK4
  return true;
}
__device__ __forceinline__ float sigm_(float x) { return __builtin_amdgcn_rcpf(1.0f + __builtin_amdgcn_exp2f(-1.4426950408889634f * x)); }
__device__ __forceinline__ void attn_unit_pp(int b, int h, int qb, int par, const bf16_t* __restrict__ QBp, const bf16_t* __restrict__ KBp, const bf16_t* __restrict__ VBp,
                                             const bf16_t* __restrict__ GBp, bf16_t* __restrict__ AOp, const bf16_t* __restrict__ PLDp, const bf16_t* __restrict__ WPLp, float lam, const float* __restrict__ sub_g, const unsigned* __restrict__ nrmk, char* lds) {
  int tid_ = threadIdx.x; asm volatile("" : "+v"(tid_));
  const int tid = tid_, wid = tid >> 6, lane = tid & 63, r32 = lane & 31, hi = lane >> 5, w4 = wid & 3, t256 = tid & 255;
  const int g = __builtin_amdgcn_readfirstlane(tid >> 8);
  const long rowbase = (long)b * SEQ; const int q0 = qb * 128;
  const size_t hoff = HEADMAJOR ? (size_t)(b * 8 + h) * SEQ * 128 : (size_t)b * SEQ * 1024 + h * 128;
  const bf16_t* Kh = KBp + hoff; const bf16_t* Vh = VBp + hoff;
  char* V_lds = lds; char* K_lds = lds + 2 * SHM_V;
  float* wsf = (float*)(lds + 2 * SHM_V + 2 * SHM_K) + wid * 64; float* li_l = wsf; float* al_l = wsf + 32;
  const float nslope = -exp2f(-(float)(h + 1)) * 1.4426950408889634f;
  const bf16_t* Qw = QBp + hoff + (size_t)(q0 + w4 * QBLK + r32) * LD + g * 64 + hi * 8;
  bf16x8 qr[4];
#pragma unroll
  for (int d0 = 0; d0 < 4; ++d0) qr[d0] = ld8(Qw + d0 * 16);
  const float qposf = (float)(q0 + w4 * QBLK + r32 - 4 * hi);
  const int sr = t256 >> 4, sc = (t256 & 15) * 8;
  int woff[4];
#pragma unroll
  for (int i = 0; i < 4; ++i) { const int row = sr + 16 * i; woff[i] = g ? (int)(2 * SHM_V) + KSWZ(row, sc * 2) : v_st(row, sc); }
  const bf16_t* Tsrc = (g ? Kh : Vh) + (long)sr * LD + sc;
  const char* Kmine = K_lds + g * 128;
  const int vb0 = (int)(uintptr_t)V_lds + v_rd_base(lane);
  float m_reg = 0.f, l_reg = 0.f, alpha = 1.f; f32x16 o[4]; f32x16 negm = f32x16{}; f32x16 p0, p1; bf16x8 pa0, pa1, pa2, pa3; bf16x8 stg[4];
#pragma unroll
  for (int d = 0; d < 4; ++d) o[d] = f32x16{};
  constexpr int NT = SEQ / KVBLK;
  float qn = 0.f;
#pragma unroll
  for (int d0 = 0; d0 < 4; ++d0) { const u32x4 w = __builtin_bit_cast(u32x4, qr[d0]);
#pragma unroll
    for (int e = 0; e < 4; ++e) { const float lo = __uint_as_float(w[e] << 16), hh = __uint_as_float(w[e] & 0xffff0000u); qn = fmaf(lo, lo, qn); qn = fmaf(hh, hh, qn); } }
  { auto rr = __builtin_amdgcn_permlane32_swap(__float_as_uint(qn), __float_as_uint(qn), false, false); qn = __uint_as_float(rr[0]) + __uint_as_float(rr[1]); }
  float sii = 0.f;
  { const bf16_t* Kw = Kh + (size_t)(q0 + w4 * QBLK + r32) * LD + g * 64 + hi * 8;
#pragma unroll
    for (int d0 = 0; d0 < 4; ++d0) { const u32x4 wq = __builtin_bit_cast(u32x4, qr[d0]); const u32x4 wk = __builtin_bit_cast(u32x4, ld8(Kw + d0 * 16));
#pragma unroll
      for (int e = 0; e < 4; ++e) { sii = fmaf(__uint_as_float(wq[e] << 16), __uint_as_float(wk[e] << 16), sii); sii = fmaf(__uint_as_float(wq[e] & 0xffff0000u), __uint_as_float(wk[e] & 0xffff0000u), sii); } } }
  { auto rr = __builtin_amdgcn_permlane32_swap(__float_as_uint(sii), __float_as_uint(sii), false, false); sii = __uint_as_float(rr[0]) + __uint_as_float(rr[1]); }
  { const unsigned* nk = nrmk + ((size_t)((b * 8 + h) * 2 + g)) * 2; const float kn = __uint_as_float(__hip_atomic_load(nk, __ATOMIC_RELAXED, __HIP_MEMORY_SCOPE_AGENT)) + __uint_as_float(__hip_atomic_load(nk + 1, __ATOMIC_RELAXED, __HIP_MEMORY_SCOPE_AGENT));
    qn = sqrtf(qn * kn) * 1.02f - sii; }
#pragma unroll
  for (int x = 1; x < 32; x <<= 1) qn = fmaxf(qn, __builtin_bit_cast(float, __builtin_amdgcn_ds_bpermute((lane ^ x) << 2, __builtin_bit_cast(int, qn))));
  float* xb = (float*)(lds + 143360 + 128) + par * 16;
  if (lane == 0) xb[wid] = qn;
  __syncthreads();
  float Bq = 0.f;
#pragma unroll
  for (int i = 0; i < 8; ++i) Bq = fmaxf(Bq, xb[i]);
  int jlo, n;
  { const float dmax = (TSKIP + Bq + 0.05f) / (-nslope);
    const float klo = (float)q0 - dmax, khi = (float)(q0 + 127) + dmax;
    int a0 = klo <= 0.f ? 0 : (int)(klo * (1.f / 64.f)); int a1 = khi >= (float)(SEQ - 1) ? NT - 1 : (int)(khi * (1.f / 64.f));
    if (((a1 - a0 + 1) & 1) != 0) { if (a0 > 0) --a0; else ++a1; }
    jlo = __builtin_amdgcn_readfirstlane(a0); n = __builtin_amdgcn_readfirstlane(a1 - a0 + 1); }
  const int dt = 2 * qb, nR = jlo + n - dt;
#define TILE(jj) ((jj) < nR ? dt + (jj) : dt - 1 - ((jj) - nR))
  float m_run = -1e30f; int live = 0;
#pragma unroll
  for (int i = 0; i < 4; ++i) stg[i] = ld8(Kh + (long)(TILE(g) * KVBLK + sr + 16 * i) * LD + sc);
#pragma unroll
  for (int i = 0; i < 4; ++i) *(bf16x8*)(K_lds + g * SHM_K + KSWZ(sr + 16 * i, sc * 2)) = stg[i];
  if (!g || n > 2) {
#pragma unroll
    for (int i = 0; i < 4; ++i) stg[i] = ld8(Tsrc + (long)(TILE(g ? 2 : 0) * KVBLK + 16 * i) * LD); }
  __syncthreads();
  if (g == 1) { __builtin_amdgcn_s_setprio(1); __syncthreads(); }
#define RESC_() do { if (__any(alpha < 1.f)) { if (hi == 0) al_l[r32] = alpha; asm volatile("s_waitcnt lgkmcnt(0)" ::: "memory"); \
    _Pragma("unroll") for (int d = 0; d < 4; ++d) _Pragma("unroll") for (int r = 0; r < 16; ++r) o[d][r] *= al_l[crow(r, hi)]; } } while (0)
#define PP_STEP(j, PAR) do { \
    qkt_c(p0, p1, Kmine + (PAR) * SHM_K, qr, negm, r32, hi); \
    if (live) pv_d0(o, vb0 + (1 - (PAR)) * (int)SHM_V, pa0, pa1, pa2, pa3); \
    __syncthreads(); \
    live = __builtin_amdgcn_readfirstlane((int)softmax_pp(p0, p1, m_reg, l_reg, negm, alpha, m_run, qposf - (float)(TILE(j) * KVBLK), nslope, pa0, pa1, pa2, pa3)); \
    RESC_(); \
    { const int wt = g ? (j) + 2 : (j); \
      if (wt < n) { _Pragma("unroll") for (int i = 0; i < 4; ++i) *(bf16x8*)(lds + woff[i] + (PAR) * 16384) = stg[i]; } \
      if (wt + 1 < n) { const int tn = TILE(wt + 1); _Pragma("unroll") for (int i = 0; i < 4; ++i) stg[i] = ld8(Tsrc + (long)(tn * KVBLK + 16 * i) * LD); } } \
    __syncthreads(); } while (0)
  _Pragma("nounroll") for (int j = 0; j < n; j += 2) { PP_STEP(j, 0); PP_STEP(j + 1, 1); }
  if (live) pv_d0(o, vb0 + (int)SHM_V, pa0, pa1, pa2, pa3);
  if (g == 0) __syncthreads();
  __builtin_amdgcn_s_setprio(0);
#undef PP_STEP
#undef RESC_
#undef TILE
  if (hi == 0) li_l[r32] = l_reg; asm volatile("s_waitcnt lgkmcnt(0)" ::: "memory");
#pragma unroll
  for (int r = 0; r < 16; ++r) { const float rl = __builtin_amdgcn_rcpf(li_l[crow(r, hi)]);
#pragma unroll
    for (int d0 = 0; d0 < 4; ++d0) o[d0][r] *= rl; }
  float* xs = (float*)(lds + SHM_X) + w4 * 4096 + lane;
  const size_t row0 = (size_t)(rowbase + q0 + w4 * QBLK + 4 * hi);
  unsigned gofs = (unsigned)((row0 * 2048 + h * 128 + r32) * 2), aofs = (unsigned)((row0 * 1024 + h * 128 + r32) * 2);
  asm volatile("" : "+v"(gofs), "+v"(aofs));
#define GATE_LD(ro_, col_) (*(const unsigned short*)((const char*)GBp + (gofs + (unsigned)(((ro_) * 2048 + (col_)) * 2))))
#define MIX_ST(ro_, col_, v_) (*(unsigned short*)((char*)AOp + (aofs + (unsigned)(((ro_) * 1024 + (col_)) * 2))) = (v_))
  float* pgs = (float*)lds + w4 * 4096 + lane;
  if (g == 1) {
    unsigned gate16[64];
#pragma unroll
    for (int r = 0; r < 16; ++r)
#pragma unroll
      for (int d0 = 0; d0 < 4; ++d0) gate16[r * 4 + d0] = GATE_LD((r & 3) + 8 * (r >> 2), 1024 + d0 * 32);
    bf16x8 pf[8];
    { const bf16_t* pr = PLDp + (size_t)(rowbase + q0 + w4 * QBLK + r32) * 512 + (h >> 1) * 128 + hi * 8;
#pragma unroll
      for (int ks = 0; ks < 8; ++ks) pf[ks] = ld8(pr + ks * 16); }
#pragma unroll
    for (int d0 = 0; d0 < 4; ++d0)
#pragma unroll
      for (int r = 0; r < 16; ++r) xs[(d0 * 16 + r) * 64] = o[d0][r];
    __syncthreads();
    const bf16_t* wpb = WPLp + (size_t)((h >> 1) * 256 + (h & 1) * 128 + r32) * 128 + hi * 8;
    float pg23[2][16];
#pragma unroll
    for (int dp = 0; dp < 2; ++dp) {
      bf16x8 wp[2][8];
#pragma unroll
      for (int e = 0; e < 2; ++e)
#pragma unroll
        for (int ks = 0; ks < 8; ++ks) wp[e][ks] = ld8(wpb + (dp * 2 + e) * 32 * 128 + ks * 16);
#pragma unroll
      for (int e = 0; e < 2; ++e) { const int d0 = dp * 2 + e; f32x16 acc = f32x16{};
#pragma unroll
        for (int ks = 0; ks < 8; ++ks) acc = __builtin_amdgcn_mfma_f32_32x32x16_bf16(pf[ks], wp[e][ks], acc, 0, 0, 0);
#pragma unroll
        for (int r = 0; r < 16; ++r) { const float pv_ = sigm_(__uint_as_float(gate16[r * 4 + d0] << 16)) * acc[r]; if (dp == 0) pgs[(d0 * 16 + r) * 64] = pv_; else pg23[e][r] = pv_; } }
    }
    __syncthreads();
#pragma unroll
    for (int e = 0; e < 2; ++e)
#pragma unroll
      for (int r = 0; r < 16; ++r) { const int ro = (r & 3) + 8 * (r >> 2), d0 = 2 + e;
        const float val = xs[(d0 * 16 + r) * 64] + pg23[e][r];
        unsigned u = __float_as_uint(val); u = (u + 0x7fffu + ((u >> 16) & 1u)) >> 16;
        MIX_ST(ro, d0 * 32, (unsigned short)u); }
  } else {
    unsigned gate16[64];
#pragma unroll
    for (int r = 0; r < 16; ++r)
#pragma unroll
      for (int d0 = 0; d0 < 4; ++d0) gate16[r * 4 + d0] = GATE_LD((r & 3) + 8 * (r >> 2), d0 * 32);
    __syncthreads();
    float ss[16];
#pragma unroll
    for (int r = 0; r < 16; ++r) ss[r] = 0.f;
#pragma unroll
    for (int d0 = 0; d0 < 4; ++d0)
#pragma unroll
      for (int r = 0; r < 16; ++r) { const float v = o[d0][r] - lam * xs[(d0 * 16 + r) * 64]; o[d0][r] = v; ss[r] += v * v; }
#pragma unroll
    for (int r = 0; r < 16; ++r) { float s = ss[r];
#pragma unroll
      for (int x = 1; x < 32; x <<= 1) s += __builtin_bit_cast(float, __builtin_amdgcn_ds_bpermute((lane ^ x) << 2, __builtin_bit_cast(int, s)));
      ss[r] = 1.0f / sqrtf(s * (1.0f / 128.0f) + 1e-5f); }
    float sg[4];
#pragma unroll
    for (int d0 = 0; d0 < 4; ++d0) sg[d0] = sub_g[d0 * 32 + r32] * 0.8f;
#pragma unroll
    for (int r = 0; r < 16; ++r)
#pragma unroll
      for (int d0 = 0; d0 < 4; ++d0) { const float ga = __uint_as_float(gate16[r * 4 + d0] << 16); o[d0][r] = o[d0][r] * ss[r] * sg[d0] * sigm_(ga); }
#pragma unroll
    for (int d0 = 2; d0 < 4; ++d0)
#pragma unroll
      for (int r = 0; r < 16; ++r) xs[(d0 * 16 + r) * 64] = o[d0][r];
    __syncthreads();
#pragma unroll
    for (int d0 = 0; d0 < 2; ++d0)
#pragma unroll
      for (int r = 0; r < 16; ++r) { const int ro = (r & 3) + 8 * (r >> 2);
        const float val = o[d0][r] + pgs[(d0 * 16 + r) * 64];
        unsigned u = __float_as_uint(val); u = (u + 0x7fffu + ((u >> 16) & 1u)) >> 16;
        MIX_ST(ro, d0 * 32, (unsigned short)u); }
  }
#undef GATE_LD
#undef MIX_ST
}
#undef SBAR
}

#define GAS __attribute__((address_space(1)))
#define LAS __attribute__((address_space(3)))
typedef unsigned short bf16;
typedef unsigned v4u __attribute__((ext_vector_type(4)));
typedef float f32x4 __attribute__((ext_vector_type(4)));
constexpr int NWAVES = 8;
constexpr size_t MiB = 1u << 20;
constexpr size_t WS_MOD = 1 * MiB;
constexpr size_t WS_MODP = 2 * MiB;
constexpr size_t WS_WIN = 14 * MiB;
constexpr size_t WS_WOUT = 25 * MiB;
constexpr size_t WS_WF1 = 27 * MiB;
constexpr size_t WS_WF2 = 38 * MiB;
constexpr size_t WS_WPL = 44 * MiB;
constexpr size_t WS_H = 80 * MiB;
constexpr size_t WS_PLD = 208 * MiB;
constexpr size_t WS_Q = 272 * MiB, WS_K = 400 * MiB, WS_V = 528 * MiB, WS_U = 656 * MiB, WS_G = 720 * MiB;
constexpr size_t WS_ACT = 272 * MiB;
constexpr size_t WS_END = 976 * MiB;
constexpr int LDS_BYTES = 147456;

#define LDS_WAIT() asm volatile("s_waitcnt lgkmcnt(0)" ::: "memory")
__device__ __forceinline__ unsigned f2bf(float f) { unsigned u = __builtin_bit_cast(unsigned, f); return (u + 0x7fffu + ((u >> 16) & 1u)) >> 16; }
__device__ __forceinline__ unsigned pk2(float lo, float hi) { return f2bf(lo) | (f2bf(hi) << 16); }
__device__ __forceinline__ float wave_sum(float v, int lane) {
#pragma unroll
    for (int o = 1; o < 64; o <<= 1) v += __builtin_bit_cast(float, __builtin_amdgcn_ds_bpermute((lane ^ o) << 2, __builtin_bit_cast(int, v)));
    return v;
}
__device__ __forceinline__ void p0_transpose_item(const float* W, int K, int N, bf16* WT, int mode, LAS float* scr, int item, int lane, const float* nscale = nullptr) {
    const int nblk = N / 32, kb = item / nblk, nb = item % nblk, k0 = 64 * kb, n0 = 32 * nb;
    int d0 = n0;
    if (mode == 1) { d0 = (n0 < DFF) ? (256 * (n0 >> 7) + (n0 & 127)) : (256 * ((n0 - DFF) >> 7) + 128 + ((n0 - DFF) & 127)); }
    const float nsc = nscale ? nscale[n0 + (lane & 31)] : 1.0f;
    float wv[32];
#pragma unroll
    for (int i = 0; i < 32; ++i) { const int kk = 2 * i + (lane >> 5); wv[i] = __builtin_nontemporal_load(&W[(size_t)(k0 + kk) * N + n0 + (lane & 31)]); }
#pragma unroll
    for (int i = 0; i < 32; ++i) { const int kk = 2 * i + (lane >> 5); scr[kk * 33 + (lane & 31)] = wv[i] * nsc; }
    LDS_WAIT(); asm volatile("" ::: "memory");
    const int c = lane & 7;
#pragma unroll
    for (int j = 0; j < 4; ++j) { const int n = (lane >> 3) + 8 * j; const LAS float* s = scr + (8 * c) * 33 + n;
        v4u o; o.x = pk2(s[0 * 33], s[1 * 33]); o.y = pk2(s[2 * 33], s[3 * 33]); o.z = pk2(s[4 * 33], s[5 * 33]); o.w = pk2(s[6 * 33], s[7 * 33]);
        *(GAS v4u*)(WT + (size_t)(d0 + n) * K + k0 + 8 * c) = o; }
    LDS_WAIT(); asm volatile("" ::: "memory");
}
__device__ __forceinline__ void p0_mod_item(const float* c, const float* w_ada, float* part, LAS float* scr, int item, int lane) {
    const int cgp = item % 96, kc = item / 96, j = cgp * 64 + lane, k0 = kc * 64;
    { float cv[32];
#pragma unroll
      for (int b = 0; b < 32; ++b) cv[b] = c[b * 1024 + k0 + lane];
#pragma unroll
      for (int b = 0; b < 32; ++b) scr[b * 64 + lane] = cv[b] / (1.0f + __expf(-cv[b])); }
    LDS_WAIT(); asm volatile("" ::: "memory");
    float acc[32];
#pragma unroll
    for (int b = 0; b < 32; ++b) acc[b] = 0.f;
    for (int kk = 0; kk < 64; kk += 8) {
        float w[8];
#pragma unroll
        for (int i = 0; i < 8; ++i) w[i] = __builtin_nontemporal_load(&w_ada[(size_t)(k0 + kk + i) * NMOD + j]);
#pragma unroll
        for (int b = 0; b < 32; ++b) { const f32x4 s0 = *(const LAS f32x4*)(scr + b * 64 + kk), s1 = *(const LAS f32x4*)(scr + b * 64 + kk + 4);
            acc[b] += (s0.x * w[0] + s0.y * w[1] + s0.z * w[2] + s0.w * w[3]) + (s1.x * w[4] + s1.y * w[5] + s1.z * w[6] + s1.w * w[7]); }
    }
#pragma unroll
    for (int b = 0; b < 32; ++b) part[(size_t)(kc * 32 + b) * NMOD + j] = acc[b];
    LDS_WAIT(); asm volatile("" ::: "memory");
}

#define XB_TMO      128
#define XB_XCNT(j)  (256  + 64 * (j))
#define XB_XSUB(j)  (1280 + 64 * (j))
#define XB_XGEN(j)  (2304 + 64 * (j))
#define XB_TOP      3328
#define XB_TOPGEN   3392
#define XCD_BAR_WORDS 3456
#define XB_SPIN_CAP (1u << 18)

__device__ __forceinline__ unsigned xb_ld(unsigned* p)              { return __hip_atomic_load(p, __ATOMIC_RELAXED, __HIP_MEMORY_SCOPE_AGENT); }
__device__ __forceinline__ unsigned xb_add(unsigned* p, unsigned v) { return __hip_atomic_fetch_add(p, v, __ATOMIC_RELAXED, __HIP_MEMORY_SCOPE_AGENT); }
__device__ __forceinline__ unsigned xb_xcc_id() { return (unsigned)__builtin_amdgcn_s_getreg((3 << 11) | 20) & 0xFu; }
#define XB_SPIN(cond, bar) do { unsigned _sp = 0; while (cond) { __builtin_amdgcn_s_sleep(1); \
    if ((++_sp & 255u) == 0u) { if (xb_ld(&(bar)[XB_TMO])) break; if (_sp > XB_SPIN_CAP) { atomicAdd(&(bar)[XB_TMO], 1u); break; } } } } while (0)

struct XcdBarrier {
    unsigned* bar; unsigned x;
    volatile LAS unsigned* st;
};

__device__ __forceinline__ XcdBarrier xcd_barrier_post(unsigned* bar, volatile LAS unsigned* st) {
    XcdBarrier b; b.bar = bar; b.x = xb_xcc_id(); b.st = st;
    if (threadIdx.x == 0) (void)xb_add(&bar[XB_XCNT(b.x)], 1u);
    return b;
}
__device__ __forceinline__ void xcd_barrier_complete(unsigned* bar, unsigned x, unsigned& nloc, unsigned& nx) {
    const unsigned G = gridDim.x * gridDim.y * gridDim.z;
    unsigned sum, cnt, mine, sp = 0u;
    for (;;) {
        sum = 0u; cnt = 0u; mine = 0u;
#pragma unroll
        for (unsigned j = 0; j < 16; ++j) { const unsigned c = xb_ld(&bar[XB_XCNT(j)]); sum += c; cnt += (c > 0u) ? 1u : 0u; mine = (j == x) ? c : mine; }
        if (sum == G) break;
        __builtin_amdgcn_s_sleep(1);
        if ((++sp & 255u) == 0u) { if (xb_ld(&bar[XB_TMO])) break; if (sp > XB_SPIN_CAP) { atomicAdd(&bar[XB_TMO], 1u); break; } }
    }
    nloc = mine > 0u ? mine : 1u; nx = cnt > 0u ? cnt : 1u;
}

__device__ __forceinline__ void xcd_barrier(const XcdBarrier& b) {
    asm volatile("s_waitcnt vmcnt(0)" ::: "memory");
    __syncthreads();
    if (threadIdx.x == 0) {
        unsigned* bar = b.bar;
        __builtin_amdgcn_s_waitcnt(0);
        unsigned nloc = b.st[0], nx = b.st[1];
        if (nloc == 0u) { xcd_barrier_complete(bar, b.x, nloc, nx); b.st[0] = nloc; b.st[1] = nx; }
        const unsigned old = xb_add(&bar[XB_XSUB(b.x)], 1u);
        const unsigned gen = old / nloc;
        if (old + 1u == (gen + 1u) * nloc) {
            __builtin_amdgcn_fence(__ATOMIC_RELEASE, "agent");
            asm volatile("s_waitcnt vmcnt(0)" ::: "memory");
            const unsigned og = xb_add(&bar[XB_TOP], 1u);
            const unsigned tg = og / nx;
            if (og + 1u == (tg + 1u) * nx) xb_add(&bar[XB_TOPGEN], 1u);
            else XB_SPIN(xb_ld(&bar[XB_TOPGEN]) == tg, bar);
            __builtin_amdgcn_fence(__ATOMIC_ACQUIRE, "agent");
            xb_add(&bar[XB_XGEN(b.x)], 1u);
            asm volatile("s_waitcnt vmcnt(0)" ::: "memory");
        } else {
            XB_SPIN(xb_ld(&bar[XB_XGEN(b.x)]) == gen, bar);
            __builtin_amdgcn_fence(__ATOMIC_ACQUIRE, "agent");
            asm volatile("s_waitcnt vmcnt(0)" ::: "memory");
        }
    }
    __syncthreads();
}

struct Args { const float* in[19]; float* out; unsigned char* ws; };
#define PHASE_IDS int t__ = threadIdx.x; asm volatile("" : "+v"(t__)); const int tid = t__, lane = tid & 63, wave = __builtin_amdgcn_readfirstlane(tid >> 6), gw = vcu * NWAVES + wave; (void)tid; (void)lane; (void)wave; (void)gw

__global__ void __launch_bounds__(NWAVES * 64) mega_fwd(Args args) {
    extern __shared__ __attribute__((aligned(16))) unsigned char lds[];
    cg::grid_group grid = cg::this_grid();
    const int tid = threadIdx.x, lane = tid & 63, wave = __builtin_amdgcn_readfirstlane(tid >> 6);
    const int G = gridDim.x, bx = blockIdx.x; int vcu = bx, gc = bx;
    const int NGW = G * NWAVES;
    unsigned char* ws = args.ws;
    unsigned* ctl = (unsigned*)ws;
    volatile LAS unsigned* misc = (volatile LAS unsigned*)((LAS unsigned char*)lds + 143360);
    if (tid < 16) misc[tid] = 0u;
    __syncthreads();
    const XcdBarrier xbar = xcd_barrier_post((unsigned*)(ws + 16384), misc + 8);
    if (tid == 0) { const unsigned xcc = (unsigned)__builtin_amdgcn_s_getreg((3 << 11) | 20) & 0xFu;
        misc[0] = xcc; misc[1] = __hip_atomic_fetch_add(ctl + 64 * xcc, 1u, __ATOMIC_RELAXED, __HIP_MEMORY_SCOPE_AGENT); }
    const float* x = args.in[0]; const float* cvec = args.in[1]; const float* w_ada = args.in[2]; const float* b_ada = args.in[3]; const float* w_in = args.in[4];
    const float* lq1 = args.in[5]; const float* lk1 = args.in[6]; const float* lq2 = args.in[7]; const float* lk2 = args.in[8]; const float* sub_g = args.in[9];
    const float* w_pool = args.in[10]; const float* pool_scale = args.in[11]; const float* w_out = args.in[12]; const float* ln1_g = args.in[13]; const float* ln1_b = args.in[14];
    const float* w_f1 = args.in[15]; const float* w_f2 = args.in[16]; const float* ln2_g = args.in[17]; const float* ln2_b = args.in[18];
    float* out = args.out;
    float* MOD = (float*)(ws + WS_MOD); float* MODP = (float*)(ws + WS_MODP);
    bf16* Wt_in = (bf16*)(ws + WS_WIN); bf16* Wt_out = (bf16*)(ws + WS_WOUT); bf16* Wt_f1 = (bf16*)(ws + WS_WF1); bf16* Wt_f2 = (bf16*)(ws + WS_WF2); bf16* Wt_pl = (bf16*)(ws + WS_WPL);
    bf16* HB = (bf16*)(ws + WS_H); bf16* PLD = (bf16*)(ws + WS_PLD);
    bf16* QB = (bf16*)(ws + WS_Q); bf16* KB = (bf16*)(ws + WS_K); bf16* VB = (bf16*)(ws + WS_V); bf16* UB = (bf16*)(ws + WS_U); bf16* GB = (bf16*)(ws + WS_G);
    bf16* ACT = (bf16*)(ws + WS_ACT);
    bf16* Y1 = (bf16*)(ws + WS_Q); bf16* Y2 = (bf16*)(ws + WS_G);
    unsigned* NRMK = (unsigned*)(ws + 8192);

    {
        PHASE_IDS;
        LAS float* scr = (LAS float*)((LAS unsigned char*)lds + wave * 16384);
        constexpr int I_IN = 16 * 176, I_OUT = 16 * 32, I_F1 = 16 * 176, I_F2 = 44 * 32, I_PL = 64, I_MOD = 96 * 16;
        constexpr int NITEMS = I_IN + I_OUT + I_F1 + I_F2 + I_PL + I_MOD;
        for (int it = gw; it < NITEMS; it += NGW) {
            int r = it;
            if (r < I_MOD) { p0_mod_item(cvec, w_ada, MODP, scr, r, lane); continue; } r -= I_MOD;
            if (r < I_IN) { p0_transpose_item(w_in, D, INC, Wt_in, 0, scr, r, lane); continue; } r -= I_IN;
            if (r < I_OUT) { p0_transpose_item(w_out, D, D, Wt_out, 0, scr, r, lane); continue; } r -= I_OUT;
            if (r < I_F1) { p0_transpose_item(w_f1, D, 2 * DFF, Wt_f1, 1, scr, r, lane); continue; } r -= I_F1;
            if (r < I_F2) { p0_transpose_item(w_f2, DFF, D, Wt_f2, 0, scr, r, lane); continue; } r -= I_F2;
            { const int g = r >> 4; p0_transpose_item(w_pool + (size_t)g * 128 * 256, 128, 256, Wt_pl + (size_t)g * 256 * 128, 0, scr, r & 15, lane, pool_scale + g * 256); }
        }
    }
    if (gridDim.y > 1) grid.sync();
    xcd_barrier(xbar);
    {
        if (threadIdx.x < 64) {
            const unsigned l_ = threadIdx.x, cj = l_ < 16u ? __hip_atomic_load(ctl + 64 * l_, __ATOMIC_RELAXED, __HIP_MEMORY_SCOPE_AGENT) : 0u;
            const unsigned xcc = misc[0], rank = misc[1]; unsigned pre = 0; bool even8 = true;
#pragma unroll
            for (int j = 0; j < 16; ++j) { const unsigned c_ = (unsigned)__builtin_amdgcn_readlane((int)cj, j);
                if ((unsigned)j < xcc) pre += c_; if (j < 8 ? (c_ * 8u != (unsigned)G) : (c_ != 0u)) even8 = false; }
            if (l_ == 0) { misc[2] = pre + rank; misc[3] = even8 ? rank * 8u + xcc : (unsigned)bx; } }
        __syncthreads();
        vcu = (int)misc[2]; gc = (int)misc[3];
        vcu = __builtin_amdgcn_readfirstlane(vcu); gc = __builtin_amdgcn_readfirstlane(gc);
    }

    {
        PHASE_IDS;
        LAS float* shsc = (LAS float*)lds;
        for (int p = vcu; p < MROWS / 256; p += G) {
            const int b = p >> 3, k8 = p & 7;
            __syncthreads();
            { float sv[5];
#pragma unroll
              for (int i = 0; i < 5; ++i) { const int j = tid + i * NWAVES * 64; const int col = j < 2048 ? j : 2048 + 512 * k8 + (j - 2048); float s = b_ada[col];
#pragma unroll
                  for (int kc = 0; kc < 16; ++kc) s += MODP[(size_t)(kc * 32 + b) * NMOD + col];
                  sv[i] = s; }
#pragma unroll
              for (int i = 0; i < 5; ++i) { const int j = tid + i * NWAVES * 64; const int col = j < 2048 ? j : 2048 + 512 * k8 + (j - 2048);
                  if (j < 2048) shsc[j] = sv[i]; else MOD[(size_t)b * NMOD + col] = sv[i]; } }
            __syncthreads();
            for (int rr = wave; rr < 256; rr += NWAVES) {
                const size_t row = (size_t)p * 256 + rr;
                const GAS f32x4* xr = (const GAS f32x4*)(x + row * D) + lane;
                f32x4 v[4]; float s = 0.f;
#pragma unroll
                for (int j = 0; j < 4; ++j) { v[j] = __builtin_nontemporal_load(&xr[64 * j]); s += (v[j].x + v[j].y) + (v[j].z + v[j].w); }
                const float mean = wave_sum(s, lane) * (1.f / D); float s2 = 0.f;
#pragma unroll
                for (int j = 0; j < 4; ++j) { v[j] = v[j] - mean; s2 += (v[j].x * v[j].x + v[j].y * v[j].y) + (v[j].z * v[j].z + v[j].w * v[j].w); }
                const float rstd = 1.f / sqrtf(wave_sum(s2, lane) * (1.f / D) + LN_EPS);
                GAS unsigned long long* o8 = (GAS unsigned long long*)(HB + row * D) + lane;
#pragma unroll
                for (int j = 0; j < 4; ++j) { const f32x4 sh = *(const LAS f32x4*)(shsc + 256 * j + 4 * lane), sc = *(const LAS f32x4*)(shsc + 1024 + 256 * j + 4 * lane);
                    const f32x4 y = v[j] * rstd * (sc + 1.0f) + sh;
                    o8[64 * j] = (unsigned long long)pk2(y.x, y.y) | ((unsigned long long)pk2(y.z, y.w) << 32); }
            }
        }
    }
    xcd_barrier(xbar);

    {
        PHASE_IDS;
        pg8::Gemm g{HB, Wt_in, MROWS, INC, D, D, D, 0}; pg8::StaticOrder S; S.init(MROWS, INC, G, gc);
        pg8::EpiProj E{QB, KB, VB, UB, GB, QSCALE, NRMK};
        pg8::gemm_phase<pg8::EpiProj, pg8::StaticOrder, true, true>((LAS unsigned char*)lds, g, S, E);
    }
    xcd_barrier(xbar);

    {
        PHASE_IDS;
        for (int chunk = gw; chunk < MROWS / 32; chunk += NGW) {
            const int row0 = chunk * 32, t0 = row0 & (SEQ - 1), gi = lane >> 4, half = 1 << gi;
            const bf16* base = UB + (size_t)(row0 - t0) * PIN + lane * 8;
            float s[8];
#pragma unroll
            for (int e = 0; e < 8; ++e) s[e] = 0.f;
#define ACC_ROW(tau, sgn) do { const v4u w_ = *(const v4u*)(base + (size_t)(tau) * PIN); \
                s[0] += (sgn) * pg8::bf_lo(w_.x); s[1] += (sgn) * pg8::bf_hi(w_.x); s[2] += (sgn) * pg8::bf_lo(w_.y); s[3] += (sgn) * pg8::bf_hi(w_.y); \
                s[4] += (sgn) * pg8::bf_lo(w_.z); s[5] += (sgn) * pg8::bf_hi(w_.z); s[6] += (sgn) * pg8::bf_lo(w_.w); s[7] += (sgn) * pg8::bf_hi(w_.w); } while (0)
            { const int lo = (t0 - half) > 0 ? (t0 - half) : 0, hi = (t0 + half) < SEQ ? (t0 + half) : SEQ;
              v4u w16[16];
#pragma unroll
              for (int q = 0; q < 16; ++q) w16[q] = *(const v4u*)(base + (size_t)((lo + q) < hi ? (lo + q) : lo) * PIN);
#pragma unroll
              for (int q = 0; q < 16; ++q) { const float m_ = (lo + q) < hi ? 1.0f : 0.0f; const v4u a_ = w16[q];
                  s[0] += m_ * pg8::bf_lo(a_.x); s[1] += m_ * pg8::bf_hi(a_.x); s[2] += m_ * pg8::bf_lo(a_.y); s[3] += m_ * pg8::bf_hi(a_.y);
                  s[4] += m_ * pg8::bf_lo(a_.z); s[5] += m_ * pg8::bf_hi(a_.z); s[6] += m_ * pg8::bf_lo(a_.w); s[7] += m_ * pg8::bf_hi(a_.w); } }
            for (int tt = 0; tt < 32; tt += 4) {
                v4u ut[4], wa[4], wr[4]; float ma[4], mr[4];
#pragma unroll
                for (int q = 0; q < 4; ++q) { const int t = t0 + tt + q, ta = t + half, tr = t - half;
                    ut[q] = *(const v4u*)(base + (size_t)t * PIN);
                    ma[q] = ta < SEQ ? 1.0f : 0.0f; wa[q] = *(const v4u*)(base + (size_t)(ta < SEQ ? ta : SEQ - 1) * PIN);
                    mr[q] = tr >= 0 ? -1.0f : 0.0f; wr[q] = *(const v4u*)(base + (size_t)(tr >= 0 ? tr : 0) * PIN); }
#pragma unroll
                for (int q = 0; q < 4; ++q) { const int t = t0 + tt + q, lo = (t - half) > 0 ? (t - half) : 0, hi = (t + half) < SEQ ? (t + half) : SEQ;
                    const float inv = 1.0f / (float)(hi - lo); const v4u u_ = ut[q];
                    v4u o; o.x = pk2(s[0] * inv - pg8::bf_lo(u_.x), s[1] * inv - pg8::bf_hi(u_.x)); o.y = pk2(s[2] * inv - pg8::bf_lo(u_.y), s[3] * inv - pg8::bf_hi(u_.y));
                    o.z = pk2(s[4] * inv - pg8::bf_lo(u_.z), s[5] * inv - pg8::bf_hi(u_.z)); o.w = pk2(s[6] * inv - pg8::bf_lo(u_.w), s[7] * inv - pg8::bf_hi(u_.w));
                    *(v4u*)(PLD + (size_t)(row0 + tt + q) * PIN + lane * 8) = o;
                    { const v4u a_ = wa[q]; const float m_ = ma[q];
                      s[0] += m_ * pg8::bf_lo(a_.x); s[1] += m_ * pg8::bf_hi(a_.x); s[2] += m_ * pg8::bf_lo(a_.y); s[3] += m_ * pg8::bf_hi(a_.y);
                      s[4] += m_ * pg8::bf_lo(a_.z); s[5] += m_ * pg8::bf_hi(a_.z); s[6] += m_ * pg8::bf_lo(a_.w); s[7] += m_ * pg8::bf_hi(a_.w); }
                    { const v4u r_ = wr[q]; const float m_ = mr[q];
                      s[0] += m_ * pg8::bf_lo(r_.x); s[1] += m_ * pg8::bf_hi(r_.x); s[2] += m_ * pg8::bf_lo(r_.y); s[3] += m_ * pg8::bf_hi(r_.y);
                      s[4] += m_ * pg8::bf_lo(r_.z); s[5] += m_ * pg8::bf_hi(r_.z); s[6] += m_ * pg8::bf_lo(r_.w); s[7] += m_ * pg8::bf_hi(r_.w); } }
            }
#undef ACC_ROW
        }
        xcd_barrier(xbar);
        const float lam = __expf(wave_sum(lq1[lane] * lk1[lane], lane)) - __expf(wave_sum(lq2[lane] * lk2[lane], lane)) + 0.2f;
        for (int i = 0, U = vcu; U < BATCH * NH * (SEQ / 128); U += G, ++i) {
            int b = U >> 7, h = (U >> 4) & 7, qb = U & 15;
            if (G == 256) { const int gi = vcu >> 4; h = (gi + i) & 7; b = i * 2 + (gi >> 3); qb = (vcu + i) & 15; }
            attn::attn_unit_pp(b, h, qb, i & 1, QB, KB, VB, GB, HB, PLD, Wt_pl, lam, sub_g, NRMK, (char*)lds);
        }
        __syncthreads();
    }
    xcd_barrier(xbar);

    {
        PHASE_IDS;
        pg8::Gemm g{HB, Wt_out, MROWS, D, D, D, D, 0}; pg8::StaticOrder S; S.init(MROWS, D, G, gc);
        pg8::EpiGate E{Y1, MOD + 2048};
        pg8::gemm_phase<pg8::EpiGate, pg8::StaticOrder, true, true>((LAS unsigned char*)lds, g, S, E);
    }
    xcd_barrier(xbar);

    {
        PHASE_IDS;
        f32x4 g1v[4], b1v[4];
#pragma unroll
        for (int j = 0; j < 4; ++j) { g1v[j] = *(const f32x4*)(ln1_g + 256 * j + 4 * lane); b1v[j] = *(const f32x4*)(ln1_b + 256 * j + 4 * lane); }
    for (int row = gw; row < MROWS; row += NGW) {
        const int b = row >> 11; const float* mb = MOD + (size_t)b * NMOD;
        GAS f32x4* zr = (GAS f32x4*)(out + (size_t)row * D) + lane;
        const GAS f32x4* xr = (const GAS f32x4*)(x + (size_t)row * D) + lane;
        const GAS unsigned long long* yr = (const GAS unsigned long long*)(Y1 + (size_t)row * D) + lane;
        f32x4 v[4]; float s = 0.f;
#pragma unroll
        for (int j = 0; j < 4; ++j) { const f32x4 xv = __builtin_nontemporal_load(&xr[64 * j]); const unsigned long long yy = __builtin_nontemporal_load(&yr[64 * j]); const unsigned ylo = (unsigned)yy, yhi = (unsigned)(yy >> 32);
            v[j] = xv * ALPHA + (f32x4){pg8::bf_lo(ylo), pg8::bf_hi(ylo), pg8::bf_lo(yhi), pg8::bf_hi(yhi)};
            s += (v[j].x + v[j].y) + (v[j].z + v[j].w); }
        float mean = wave_sum(s, lane) * (1.f / D), s2 = 0.f;
#pragma unroll
        for (int j = 0; j < 4; ++j) { v[j] = v[j] - mean; s2 += (v[j].x * v[j].x + v[j].y * v[j].y) + (v[j].z * v[j].z + v[j].w * v[j].w); }
        float rstd = 1.f / sqrtf(wave_sum(s2, lane) * (1.f / D) + LN_EPS);
        s = 0.f;
#pragma unroll
        for (int j = 0; j < 4; ++j) { const f32x4 gg = g1v[j], bb = b1v[j];
            v[j] = v[j] * rstd * gg + bb; __builtin_nontemporal_store(v[j], &zr[64 * j]); s += (v[j].x + v[j].y) + (v[j].z + v[j].w); }
        mean = wave_sum(s, lane) * (1.f / D); s2 = 0.f;
#pragma unroll
        for (int j = 0; j < 4; ++j) { v[j] = v[j] - mean; s2 += (v[j].x * v[j].x + v[j].y * v[j].y) + (v[j].z * v[j].z + v[j].w * v[j].w); }
        rstd = 1.f / sqrtf(wave_sum(s2, lane) * (1.f / D) + LN_EPS);
        GAS unsigned long long* o8 = (GAS unsigned long long*)(HB + (size_t)row * D) + lane;
#pragma unroll
        for (int j = 0; j < 4; ++j) { const f32x4 sh = *(const f32x4*)(mb + 3072 + 256 * j + 4 * lane), sc = *(const f32x4*)(mb + 4096 + 256 * j + 4 * lane);
            const f32x4 y = v[j] * rstd * (sc + 1.0f) + sh;
            o8[64 * j] = (unsigned long long)pk2(y.x, y.y) | ((unsigned long long)pk2(y.z, y.w) << 32); }
    }
    }
    xcd_barrier(xbar);

    {
        PHASE_IDS;
        pg8::Gemm g{HB, Wt_f1, MROWS, 2 * DFF, D, D, D, 0}; pg8::StaticOrder S; S.init(MROWS, 2 * DFF, G, gc);
        pg8::EpiSwiglu E{ACT};
        pg8::gemm_phase<pg8::EpiSwiglu, pg8::StaticOrder, true, true>((LAS unsigned char*)lds, g, S, E);
    }
    xcd_barrier(xbar);

    {
        PHASE_IDS;
        pg8::Gemm g{ACT, Wt_f2, MROWS, D, DFF, DFF, DFF, 0}; pg8::StaticOrder S; S.init(MROWS, D, G, gc);
        pg8::EpiGate E{Y2, MOD + 5120};
        pg8::gemm_phase<pg8::EpiGate, pg8::StaticOrder, true, true>((LAS unsigned char*)lds, g, S, E);
    }
    xcd_barrier(xbar);

    {
        PHASE_IDS;
        f32x4 g2v[4], b2v[4];
#pragma unroll
        for (int jj = 0; jj < 4; ++jj) { g2v[jj] = *(const f32x4*)(ln2_g + 256 * jj + 4 * lane); b2v[jj] = *(const f32x4*)(ln2_b + 256 * jj + 4 * lane); }
    for (int row = gw; row < MROWS; row += NGW) {
        GAS f32x4* zr = (GAS f32x4*)(out + (size_t)row * D) + lane;
        const GAS unsigned long long* yr = (const GAS unsigned long long*)(Y2 + (size_t)row * D) + lane;
        f32x4 v[4]; float s = 0.f;
#pragma unroll
        for (int j = 0; j < 4; ++j) { const f32x4 xv = __builtin_nontemporal_load(&zr[64 * j]); const unsigned long long yy = __builtin_nontemporal_load(&yr[64 * j]); const unsigned ylo = (unsigned)yy, yhi = (unsigned)(yy >> 32);
            v[j] = xv * ALPHA + (f32x4){pg8::bf_lo(ylo), pg8::bf_hi(ylo), pg8::bf_lo(yhi), pg8::bf_hi(yhi)};
            s += (v[j].x + v[j].y) + (v[j].z + v[j].w); }
        const float mean = wave_sum(s, lane) * (1.f / D); float s2 = 0.f;
#pragma unroll
        for (int j = 0; j < 4; ++j) { v[j] = v[j] - mean; s2 += (v[j].x * v[j].x + v[j].y * v[j].y) + (v[j].z * v[j].z + v[j].w * v[j].w); }
        const float rstd = 1.f / sqrtf(wave_sum(s2, lane) * (1.f / D) + LN_EPS);
#pragma unroll
        for (int j = 0; j < 4; ++j) { const f32x4 gg = g2v[j], bb = b2v[j];
            __builtin_nontemporal_store(v[j] * rstd * gg + bb, &zr[64 * j]); }
    }
    }
}

extern "C" void kernel_launch(void* const* d_in, const int* in_sizes, int n_in, void* d_out, int out_size, void* d_ws, size_t ws_size, hipStream_t stream) {
    static int grid = 0;
    if (grid == 0) {
        if (n_in != 19 || in_sizes[0] != MROWS * D || out_size != MROWS * D || ws_size < WS_END) {
            fprintf(stderr, "kernel_launch: shape mismatch: n_in %d in0 %d out %d ws %zu (need >= %zu)\n", n_in, n_in > 0 ? in_sizes[0] : -1, out_size, ws_size, (size_t)WS_END); grid = -1; return; }
        int dev = 0, cus = 0, per_cu = 0;
        if (hipGetDevice(&dev) != hipSuccess || hipDeviceGetAttribute(&cus, hipDeviceAttributeMultiprocessorCount, dev) != hipSuccess) { grid = -1; return; }
        if (hipFuncSetAttribute((const void*)mega_fwd, hipFuncAttributeMaxDynamicSharedMemorySize, LDS_BYTES) != hipSuccess) { fprintf(stderr, "kernel_launch: hipFuncSetAttribute failed\n"); grid = -1; return; }
        if (hipOccupancyMaxActiveBlocksPerMultiprocessor(&per_cu, (const void*)mega_fwd, NWAVES * 64, LDS_BYTES) != hipSuccess || per_cu < 1) { fprintf(stderr, "kernel_launch: occupancy query gave %d\n", per_cu); per_cu = 1; }
        (void)hipGetLastError();
        grid = cus * per_cu; if (grid > 256) grid = 256;
    }
    if (grid < 0) return;
    if (hipMemsetAsync(d_ws, 0, 32768, stream) != hipSuccess) { fprintf(stderr, "kernel_launch: memset failed\n"); return; }
    Args a{};
    for (int i = 0; i < 19; ++i) a.in[i] = (const float*)d_in[i];
    a.out = (float*)d_out; a.ws = (unsigned char*)d_ws;
    void* kargs[] = {&a};
    const hipError_t e = hipLaunchCooperativeKernel((const void*)mega_fwd, dim3(grid), dim3(NWAVES * 64), kargs, LDS_BYTES, stream);
    if (e != hipSuccess) fprintf(stderr, "kernel_launch: cooperative launch failed: %s (grid %d)\n", hipGetErrorString(e), grid);
}
```

```cpp
#include <hip/hip_runtime.h>
#include <hip/hip_cooperative_groups.h>
#include <cstdio>
#include <cstdint>
namespace cg = cooperative_groups;

constexpr int D = 1024, BATCH = 32, SEQ = 2048, MROWS = BATCH * SEQ, NH = 8, INC = 5632, DFF = 2816, PIN = 512, NMOD = 6144;
constexpr float ALPHA = 1.189207115002721f;
constexpr float LN_EPS = 1e-5f, RMS_EPS = 1e-5f;
constexpr float LOG2E = 1.4426950408889634f;
constexpr float QSCALE = 0.125f * LOG2E;

#ifndef HEADMAJOR
#define HEADMAJOR 1
#endif
namespace pg8 {
#define PG8_LAS __attribute__((address_space(3)))
typedef unsigned short bf16_t;
typedef short bf16x8 __attribute__((ext_vector_type(8)));
typedef float f32x4 __attribute__((ext_vector_type(4)));
typedef unsigned u32x4 __attribute__((ext_vector_type(4)));
constexpr int BM = 256, BK = 64, HALF = 128, HTB = HALF * BK * 2  , STAGE_BYTES = 8 * HTB, NXCD = 8, WGM = 8;

__host__ __device__ __forceinline__ int lds_byte(int r, int c) { const int st = (r >> 4) * 2 + (c >> 5), rr = r & 15, cc = c & 31, ob = rr * 64 + cc * 2; return st * 1024 + (ob ^ (((ob >> 9) & 1) << 5)); }
__host__ __device__ __forceinline__ void stage_rc(int b, int& R, int& C) { const int st = b / 1024, sb = b % 1024, swz = sb ^ (((sb >> 9) & 1) << 5); R = (st >> 1) * 16 + swz / 64; C = (st & 1) * 32 + (swz % 64) / 2; }
__host__ __device__ __forceinline__ int perm32(int rho) { const int n = rho >> 4, i = rho & 15; return 8 * (i >> 2) + 4 * n + (i & 3); }

struct Unit { int pm, pn; };
struct Gemm { const bf16_t* A; const bf16_t* Bt; int M, N, K, lda, ldb, apn; };

struct StaticOrder {
    int nM, nN, nwg, G, c;
    __host__ __device__ void init(int M, int N, int G_, int c_) { nM = M / BM; nN = N / BM; nwg = nM * nN; G = G_; c = c_; }
    __host__ __device__ bool next(int i, Unit& u) const {
        const long L = (long)i * G + c; if (L >= nwg) return false;
        int wgid = (int)L; { const int q = nwg / NXCD, r = nwg % NXCD, xcd = wgid % NXCD, off = wgid / NXCD; wgid = (xcd < r ? xcd * (q + 1) : r * (q + 1) + (xcd - r) * q) + off; }
        const int nig = WGM * nN, gid = wgid / nig, fm = gid * WGM, gsz = (nM - fm) < WGM ? (nM - fm) : WGM;
        u.pm = fm + ((wgid % nig) % gsz); u.pn = (wgid % nig) / gsz; return true;
    }
    __device__ __forceinline__ void a_ready(const Unit&) const {}
    __device__ __forceinline__ void done(const Unit&) const {}
};


__device__ __forceinline__ unsigned cvt_pk_bf16(float lo, float hi) { unsigned r; asm volatile("v_cvt_pk_bf16_f32 %0, %1, %2" : "=v"(r) : "v"(lo), "v"(hi)); return r; }
__device__ __forceinline__ float bf_lo(unsigned w) { return __uint_as_float(w << 16); }
__device__ __forceinline__ float bf_hi(unsigned w) { return __uint_as_float(w & 0xffff0000u); }
__device__ __forceinline__ float sigm(float x) { return __builtin_amdgcn_rcpf(1.0f + __builtin_amdgcn_exp2f(-1.4426950408889634f * x)); }

struct EpiProj {
    static constexpr bool PERM = true, AFTER_DRAIN = false;
    bf16_t *Q, *Kb, *V, *U, *G; float qscale; unsigned* nrmk;
    __device__ __forceinline__ void operator()(const f32x4 (&acc)[2][2][4][2], const Unit& u, int wr, int wc, int fr, int fq) const {
        const int pn = u.pn;
        if (pn >= 4 && pn < 8) {
            const int lane = fq * 16 + fr;
#pragma unroll
            for (int bj = 0; bj < 2; ++bj) { float mx = 0.f;
#pragma unroll
                for (int ai = 0; ai < 2; ++ai)
#pragma unroll
                    for (int m = 0; m < 4; ++m) { const f32x4 a = acc[ai][bj][m][0], c = acc[ai][bj][m][1];
                        float s = (a[0] * a[0] + a[1] * a[1]) + (a[2] * a[2] + a[3] * a[3]) + (c[0] * c[0] + c[1] * c[1]) + (c[2] * c[2] + c[3] * c[3]);
                        s += __builtin_bit_cast(float, __builtin_amdgcn_ds_bpermute((lane ^ 16) << 2, __builtin_bit_cast(int, s)));
                        s += __builtin_bit_cast(float, __builtin_amdgcn_ds_bpermute((lane ^ 32) << 2, __builtin_bit_cast(int, s)));
                        mx = fmaxf(mx, s); }
#pragma unroll
                for (int x = 1; x < 16; x <<= 1) mx = fmaxf(mx, __builtin_bit_cast(float, __builtin_amdgcn_ds_bpermute((lane ^ x) << 2, __builtin_bit_cast(int, mx))));
                if (lane == 0) atomicMax(nrmk + (((u.pm >> 3) * 8 + 2 * (pn - 4) + bj) * 2 + (wc >> 1)) * 2 + (wc & 1), __float_as_uint(mx)); }
        }
        if (HEADMAJOR && pn < 12) {
            bf16_t* base; int ct; float sc = 1.f;
            if (pn < 4) { base = Q; ct = pn; sc = qscale; } else if (pn < 8) { base = Kb; ct = pn - 4; } else { base = V; ct = pn - 8; }
            const int b = u.pm >> 3, t0 = (u.pm & 7) * BM + wr * 64 + fr;
#pragma unroll
            for (int bj = 0; bj < 2; ++bj) { bf16_t* hb = base + ((size_t)((b * 8 + 2 * ct + bj) * 2048 + t0)) * 128 + wc * 32 + 8 * fq;
#pragma unroll
                for (int ai = 0; ai < 2; ++ai)
#pragma unroll
                    for (int m = 0; m < 4; ++m) { const f32x4 v0 = acc[ai][bj][m][0] * sc, v1 = acc[ai][bj][m][1] * sc;
                        u32x4 w; w.x = cvt_pk_bf16(v0[0], v0[1]); w.y = cvt_pk_bf16(v0[2], v0[3]); w.z = cvt_pk_bf16(v1[0], v1[1]); w.w = cvt_pk_bf16(v1[2], v1[3]);
                        __builtin_nontemporal_store(w, (u32x4*)(hb + (ai * HALF + m * 16) * 128)); } }
        } else {
            bf16_t* base; int ld, ct; float sc = 1.f;
            if (pn < 4) { base = Q; ld = 1024; ct = pn; sc = qscale; } else if (pn < 8) { base = Kb; ld = 1024; ct = pn - 4; } else if (pn < 12) { base = V; ld = 1024; ct = pn - 8; }
            else if (pn < 14) { base = U; ld = 512; ct = pn - 12; } else { base = G; ld = 2048; ct = pn - 14; }
            const int row0 = u.pm * BM + wr * 64 + fr, col0 = ct * 256 + wc * 32 + 8 * fq;
#pragma unroll
            for (int ai = 0; ai < 2; ++ai)
#pragma unroll
                for (int m = 0; m < 4; ++m) { bf16_t* rowp = base + (size_t)(row0 + ai * HALF + m * 16) * ld + col0;
#pragma unroll
                    for (int bj = 0; bj < 2; ++bj) { const f32x4 v0 = acc[ai][bj][m][0] * sc, v1 = acc[ai][bj][m][1] * sc;
                        u32x4 w; w.x = cvt_pk_bf16(v0[0], v0[1]); w.y = cvt_pk_bf16(v0[2], v0[3]); w.z = cvt_pk_bf16(v1[0], v1[1]); w.w = cvt_pk_bf16(v1[2], v1[3]);
                        __builtin_nontemporal_store(w, (u32x4*)(rowp + bj * HALF)); } }
        }
    }
};
struct EpiGate {
    static constexpr bool PERM = true, AFTER_DRAIN = false;
    bf16_t* out; const float* gate;
    __device__ __forceinline__ void operator()(const f32x4 (&acc)[2][2][4][2], const Unit& u, int wr, int wc, int fr, int fq) const {
        const int row0 = u.pm * BM + wr * 64 + fr, col0 = u.pn * 256 + wc * 32 + 8 * fq;
        const float* gp = gate + (size_t)(u.pm >> 3) * 6144 + col0;
        f32x4 gq[2][2];
#pragma unroll
        for (int bj = 0; bj < 2; ++bj) { gq[bj][0] = *(const f32x4*)(gp + bj * HALF); gq[bj][1] = *(const f32x4*)(gp + bj * HALF + 4); }
#pragma unroll
        for (int bj = 0; bj < 2; ++bj) { const f32x4 g0 = gq[bj][0], g1 = gq[bj][1];
#pragma unroll
            for (int ai = 0; ai < 2; ++ai)
#pragma unroll
                for (int m = 0; m < 4; ++m) { const f32x4 v0 = acc[ai][bj][m][0] * g0, v1 = acc[ai][bj][m][1] * g1;
                    u32x4 w; w.x = cvt_pk_bf16(v0[0], v0[1]); w.y = cvt_pk_bf16(v0[2], v0[3]); w.z = cvt_pk_bf16(v1[0], v1[1]); w.w = cvt_pk_bf16(v1[2], v1[3]);
                    *(u32x4*)(out + (size_t)(row0 + ai * HALF + m * 16) * 1024 + col0 + bj * HALF) = w; } }
    }
};
struct EpiSwiglu {
    static constexpr bool PERM = true, AFTER_DRAIN = false;
    bf16_t* out;
    __device__ __forceinline__ void operator()(const f32x4 (&acc)[2][2][4][2], const Unit& u, int wr, int wc, int fr, int fq) const {
        const int row0 = u.pm * BM + wr * 64 + fr, col0 = u.pn * 128 + wc * 32 + 8 * fq;
#pragma unroll
        for (int ai = 0; ai < 2; ++ai)
#pragma unroll
            for (int m = 0; m < 4; ++m) { bf16_t* rowp = out + (size_t)(row0 + ai * HALF + m * 16) * 2816 + col0;
                const f32x4 g0 = acc[ai][0][m][0], g1 = acc[ai][0][m][1], u0 = acc[ai][1][m][0], u1 = acc[ai][1][m][1];
                u32x4 w;
                w.x = cvt_pk_bf16(g0[0] * sigm(g0[0]) * u0[0], g0[1] * sigm(g0[1]) * u0[1]);
                w.y = cvt_pk_bf16(g0[2] * sigm(g0[2]) * u0[2], g0[3] * sigm(g0[3]) * u0[3]);
                w.z = cvt_pk_bf16(g1[0] * sigm(g1[0]) * u1[0], g1[1] * sigm(g1[1]) * u1[1]);
                w.w = cvt_pk_bf16(g1[2] * sigm(g1[2]) * u1[2], g1[3] * sigm(g1[3]) * u1[3]);
                __builtin_nontemporal_store(w, (u32x4*)rowp); }
    }
};

template <class Epi, class Sched, bool ALIGN_EPI = false, bool SP2 = false>
__device__ __forceinline__ void gemm_phase(PG8_LAS unsigned char* lds, const Gemm g, const Sched& S, const Epi& E) {
    int tid_ = threadIdx.x; asm volatile("" : "+v"(tid_));
    const int tid = tid_, wid = __builtin_amdgcn_readfirstlane(tid >> 6), lane = tid & 63, wr = wid >> 2, wc = wid & 3, fr = lane & 15, fq = lane >> 4;
    const int K = g.K, nt = K / BK;
    unsigned voffA[2], voffB[2];
#pragma unroll
    for (int i = 0; i < 2; ++i) { int R, C; stage_rc(tid * 16 + i * 8192, R, C); const int Rb = Epi::PERM ? ((R & ~31) + perm32(R & 31)) : R;
        voffA[i] = (unsigned)(R * g.lda + C) * 2u; voffB[i] = (unsigned)(Rb * g.ldb + C) * 2u; }
    const size_t kstep = (size_t)(BK * 2);
    const size_t hstepA = (size_t)HALF * g.lda * 2, hstepB = (size_t)HALF * g.ldb * 2;
    const size_t tstepA = 2 * hstepA, tstepB = 2 * hstepB, apn = (size_t)g.apn;
    const unsigned ldsw = (unsigned)wid * 1024u;
    const int aoff = lds_byte(wr * 64 + fr, fq * 8), boff = lds_byte(wc * 32 + fr, fq * 8);
#define PG8_SA(b, h) (((b) * 2 + (h)) * HTB)
#define PG8_SB(b, h) ((4 + (b) * 2 + (h)) * HTB)
#define PG8_STAGE(bufoff, gbase, voff) do { _Pragma("unroll") for (int _i = 0; _i < 2; ++_i) \
        __builtin_amdgcn_global_load_lds((const unsigned*)((const char*)(gbase) + (voff)[_i]), (PG8_LAS unsigned*)(lds + (bufoff) + ldsw + _i * 8192), 16, 0, 0); } while (0)
#define PG8_LDA(dst, b, h) do { _Pragma("unroll") for (int m = 0; m < 4; ++m) _Pragma("unroll") for (int k = 0; k < 2; ++k) dst[m][k] = *(const PG8_LAS bf16x8*)(lds + PG8_SA(b, h) + aoff + m * 2048 + k * 1024); } while (0)
#define PG8_LDB(dst, b, h) do { _Pragma("unroll") for (int n = 0; n < 2; ++n) _Pragma("unroll") for (int k = 0; k < 2; ++k) dst[n][k] = *(const PG8_LAS bf16x8*)(lds + PG8_SB(b, h) + boff + n * 2048 + k * 1024); } while (0)
#define PG8_MMA(ai, bj, At, Bt) do { __builtin_amdgcn_s_setprio(1); _Pragma("unroll") for (int m = 0; m < 4; ++m) _Pragma("unroll") for (int n = 0; n < 2; ++n) _Pragma("unroll") for (int k = 0; k < 2; ++k) \
        acc[ai][bj][m][n] = __builtin_amdgcn_mfma_f32_16x16x32_bf16(Bt[n][k], At[m][k], acc[ai][bj][m][n], 0, 0, 0); __builtin_amdgcn_s_setprio(0); } while (0)
#define PG8_WAIT_V(n) asm volatile("s_waitcnt vmcnt(" #n ")" ::: "memory")
#define PG8_WAIT_L(n) asm volatile("s_waitcnt lgkmcnt(" #n ")" ::: "memory")
#define PG8_BAR __builtin_amdgcn_s_barrier()
#define PG8_SCHED __builtin_amdgcn_sched_barrier(0)
    Unit cur, nxt; int ui = 0;
    if (!S.next(0, cur)) return;
    f32x4 acc[2][2][4][2];
#pragma unroll
    for (int a = 0; a < 2; ++a)
#pragma unroll
        for (int b = 0; b < 2; ++b)
#pragma unroll
            for (int m = 0; m < 4; ++m)
#pragma unroll
                for (int n = 0; n < 2; ++n) acc[a][b][m][n] = (f32x4){0.f, 0.f, 0.f, 0.f};
    bf16x8 At[4][2], B0[2][2], B1[2][2];
    const char* cA = (const char*)g.A + (size_t)cur.pm * tstepA + (size_t)cur.pn * apn; const char* cB = (const char*)g.Bt + (size_t)cur.pn * tstepB;
    S.a_ready(cur);
    if constexpr (SP2) {
        PG8_STAGE(PG8_SB(0, 0), cB, voffB); PG8_STAGE(PG8_SB(0, 1), cB + hstepB, voffB); PG8_STAGE(PG8_SA(0, 0), cA, voffA); PG8_STAGE(PG8_SA(0, 1), cA + hstepA, voffA);
        if (wr == 1) PG8_BAR;
        PG8_WAIT_V(2); PG8_BAR;
        PG8_STAGE(PG8_SB(1, 0), cB + kstep, voffB); PG8_STAGE(PG8_SA(1, 0), cA + kstep, voffA); PG8_STAGE(PG8_SB(1, 1), cB + hstepB + kstep, voffB);
        PG8_WAIT_V(6); PG8_BAR;
    } else {
        PG8_STAGE(PG8_SB(0, 0), cB, voffB); PG8_STAGE(PG8_SA(0, 0), cA, voffA); PG8_STAGE(PG8_SB(0, 1), cB + hstepB, voffB); PG8_STAGE(PG8_SA(0, 1), cA + hstepA, voffA);
        if (wr == 1) PG8_BAR;
        PG8_WAIT_V(4); PG8_BAR;
        PG8_STAGE(PG8_SB(1, 0), cB + kstep, voffB); PG8_STAGE(PG8_SA(1, 0), cA + kstep, voffA); PG8_STAGE(PG8_SB(1, 1), cB + hstepB + kstep, voffB);
        PG8_WAIT_V(6); PG8_BAR;
    }
    for (;;) {
        const bool has_next = S.next(ui + 1, nxt);
        const char* nA = has_next ? (const char*)g.A + (size_t)nxt.pm * tstepA + (size_t)nxt.pn * apn : cA; const char* nB = has_next ? (const char*)g.Bt + (size_t)nxt.pn * tstepB : cB;
        for (int t = 0; t < nt; t += 2) {
            const bool last = (t == nt - 2);
            const char* a1 = cA + (size_t)(t + 1) * kstep;
            const char* a2 = last ? nA : cA + (size_t)(t + 2) * kstep; const char* b2 = last ? nB : cB + (size_t)(t + 2) * kstep;
            const char* a3 = a2 + kstep; const char* b3 = b2 + kstep;
            if (last && has_next) S.a_ready(nxt);
            if constexpr (SP2) {
            PG8_LDB(B0, 0, 0); PG8_LDB(B1, 0, 1); PG8_SCHED; PG8_LDA(At, 0, 0); PG8_STAGE(PG8_SA(1, 1), a1 + hstepA, voffA);
            PG8_WAIT_V(8); PG8_WAIT_L(0); PG8_BAR; PG8_MMA(0, 0, At, B0); PG8_MMA(0, 1, At, B1); PG8_BAR; PG8_SCHED;
            PG8_LDA(At, 0, 1); PG8_STAGE(PG8_SB(0, 0), b2, voffB); PG8_STAGE(PG8_SB(0, 1), b2 + hstepB, voffB); PG8_STAGE(PG8_SA(0, 0), a2, voffA);
            PG8_WAIT_V(8); PG8_WAIT_L(0); PG8_BAR; PG8_MMA(1, 0, At, B0); PG8_MMA(1, 1, At, B1); PG8_BAR; PG8_SCHED;
            PG8_LDB(B0, 1, 0); PG8_LDB(B1, 1, 1); PG8_SCHED; PG8_LDA(At, 1, 0); PG8_STAGE(PG8_SA(0, 1), a2 + hstepA, voffA);
            PG8_WAIT_V(8); PG8_WAIT_L(0); PG8_BAR; PG8_MMA(0, 0, At, B0); PG8_MMA(0, 1, At, B1); PG8_BAR; PG8_SCHED;
            PG8_LDA(At, 1, 1); PG8_STAGE(PG8_SB(1, 0), b3, voffB); PG8_STAGE(PG8_SB(1, 1), b3 + hstepB, voffB); PG8_STAGE(PG8_SA(1, 0), a3, voffA);
            PG8_WAIT_V(8); PG8_WAIT_L(0); PG8_BAR; PG8_MMA(1, 0, At, B0); PG8_MMA(1, 1, At, B1); PG8_BAR; PG8_SCHED;
            } else {
            PG8_LDB(B0, 0, 0); PG8_SCHED; PG8_LDA(At, 0, 0); PG8_STAGE(PG8_SA(1, 1), a1 + hstepA, voffA);
            PG8_WAIT_L(8); PG8_BAR; PG8_WAIT_L(0); PG8_MMA(0, 0, At, B0); PG8_BAR; PG8_SCHED;
            PG8_LDB(B1, 0, 1); PG8_STAGE(PG8_SB(0, 0), b2, voffB);
            PG8_BAR; PG8_WAIT_L(0); PG8_MMA(0, 1, At, B1); PG8_BAR;
            PG8_LDA(At, 0, 1); PG8_STAGE(PG8_SA(0, 0), a2, voffA);
            PG8_BAR; PG8_WAIT_L(0); PG8_MMA(1, 0, At, B0); PG8_BAR; PG8_SCHED;
            PG8_STAGE(PG8_SB(0, 1), b2 + hstepB, voffB);
            PG8_WAIT_V(6); PG8_BAR; PG8_MMA(1, 1, At, B1); PG8_BAR;
            PG8_LDB(B0, 1, 0); PG8_SCHED; PG8_LDA(At, 1, 0); PG8_STAGE(PG8_SA(0, 1), a2 + hstepA, voffA);
            PG8_WAIT_L(8); PG8_BAR; PG8_WAIT_L(0); PG8_MMA(0, 0, At, B0); PG8_BAR; PG8_SCHED;
            PG8_LDB(B1, 1, 1); PG8_STAGE(PG8_SB(1, 0), b3, voffB);
            PG8_BAR; PG8_WAIT_L(0); PG8_MMA(0, 1, At, B1); PG8_BAR;
            PG8_LDA(At, 1, 1); PG8_STAGE(PG8_SA(1, 0), a3, voffA);
            PG8_BAR; PG8_WAIT_L(0); PG8_MMA(1, 0, At, B0); PG8_BAR; PG8_SCHED;
            PG8_STAGE(PG8_SB(1, 1), b3 + hstepB, voffB);
            PG8_WAIT_V(6); PG8_BAR; PG8_MMA(1, 1, At, B1); PG8_BAR;
            }
        }
        if constexpr (ALIGN_EPI) { if (wr == 0) PG8_BAR; }
        if constexpr (!Epi::AFTER_DRAIN) { E(acc, cur, wr, wc, fr, fq); S.done(cur); }
        if (!has_next) break;
#pragma unroll
        for (int a = 0; a < 2; ++a)
#pragma unroll
            for (int b = 0; b < 2; ++b)
#pragma unroll
                for (int m = 0; m < 4; ++m)
#pragma unroll
                    for (int n = 0; n < 2; ++n) acc[a][b][m][n] = (f32x4){0.f, 0.f, 0.f, 0.f};
        cur = nxt; cA = nA; cB = nB; ++ui;
        if constexpr (ALIGN_EPI) { if (wr == 1) PG8_BAR; }
    }
    PG8_WAIT_V(0);
    if constexpr (!ALIGN_EPI) { if (wr == 0) PG8_BAR; }
    PG8_BAR;
    if constexpr (Epi::AFTER_DRAIN) { E.fused(acc, cur, wr, wc, fr, fq, lds, wid, lane); S.done(cur); }
#undef PG8_SA
#undef PG8_SB
#undef PG8_STAGE
#undef PG8_LDA
#undef PG8_LDB
#undef PG8_MMA
#undef PG8_WAIT_V
#undef PG8_WAIT_L
#undef PG8_BAR
#undef PG8_SCHED
}
}

namespace attn {
typedef unsigned short bf16_t;
using bf16x8 = __attribute__((ext_vector_type(8))) short;
using s16x4  = __attribute__((ext_vector_type(4))) short;
using f32x16 = __attribute__((ext_vector_type(16))) float;
using u32x4  = __attribute__((ext_vector_type(4))) unsigned;
constexpr int NW = 8, QBLK = 32, KVBLK = 64, LD = HEADMAJOR ? 128 : 1024;
constexpr size_t SHM_V = KVBLK * 128 * 2, SHM_K = KVBLK * 128 * 2, SHM_ATTN = 2 * SHM_V + 2 * SHM_K + NW * 64 * 4;
#ifndef ATT_REP
#define ATT_REP 1
#endif
constexpr float TSKIP = 40.f;
constexpr float THRL = 11.5f;
#define KSWZ(row, colB) ((row) * 256 + ((colB) ^ (((row) & 7) << 4)))
#define SBAR() __builtin_amdgcn_sched_barrier(0)
__device__ __forceinline__ int crow(int r, int hi) { return (r & 3) + 8 * (r >> 2) + 4 * hi; }
__device__ __forceinline__ unsigned cvtpk(float lo, float hi) { unsigned r; asm volatile("v_cvt_pk_bf16_f32 %0, %1, %2" : "=v"(r) : "v"(lo), "v"(hi)); return r; }
__device__ __forceinline__ bf16x8 ld8(const bf16_t* p) { return *reinterpret_cast<const bf16x8*>(p); }

__device__ __forceinline__ int v_st(int k, int c) { const int kk = (k & ~0xC) | ((k & 4) << 1) | ((k & 8) >> 1); return ((kk >> 3) * 4 + (c >> 5)) * 512 + ((kk & 7) * 32 + (c & 31)) * 2; }
__device__ __forceinline__ int v_rd_base(int lane) { return ((lane & 3) << 3) | (((lane >> 2) & 3) << 6) | (((lane >> 4) & 1) << 5) | (((lane >> 5) & 1) << 8); }
constexpr int v_rd_off(int d0, int ks, int half) { return d0 * 512 + ks * 4096 + half * 2048; }
template <int OFF> __device__ __forceinline__ s16x4 tr_read(int vb) {
  s16x4 r; asm volatile("ds_read_b64_tr_b16 %0, %1 offset:%2" : "=&v"(r) : "v"(vb), "i"(OFF) : "memory"); return r;
}
template <int D0> __device__ __forceinline__ void pv_one(f32x16& od, int vb, bf16x8 pa0, bf16x8 pa1, bf16x8 pa2, bf16x8 pa3) {
  const s16x4 l0 = tr_read<v_rd_off(D0, 0, 0)>(vb), h0 = tr_read<v_rd_off(D0, 0, 1)>(vb), l1 = tr_read<v_rd_off(D0, 1, 0)>(vb), h1 = tr_read<v_rd_off(D0, 1, 1)>(vb);
  const s16x4 l2 = tr_read<v_rd_off(D0, 2, 0)>(vb), h2 = tr_read<v_rd_off(D0, 2, 1)>(vb), l3 = tr_read<v_rd_off(D0, 3, 0)>(vb), h3 = tr_read<v_rd_off(D0, 3, 1)>(vb);
  asm volatile("s_waitcnt lgkmcnt(0)" ::: "memory"); SBAR();
#define PK(L, H) (bf16x8){L[0], L[1], L[2], L[3], H[0], H[1], H[2], H[3]}
  od = __builtin_amdgcn_mfma_f32_32x32x16_bf16(pa0, PK(l0, h0), od, 0, 0, 0);
  od = __builtin_amdgcn_mfma_f32_32x32x16_bf16(pa1, PK(l1, h1), od, 0, 0, 0);
  od = __builtin_amdgcn_mfma_f32_32x32x16_bf16(pa2, PK(l2, h2), od, 0, 0, 0);
  od = __builtin_amdgcn_mfma_f32_32x32x16_bf16(pa3, PK(l3, h3), od, 0, 0, 0);
#undef PK
}
__device__ __forceinline__ void pv_d0(f32x16* o, int vb, bf16x8 pa0, bf16x8 pa1, bf16x8 pa2, bf16x8 pa3) {
  pv_one<0>(o[0], vb, pa0, pa1, pa2, pa3); pv_one<1>(o[1], vb, pa0, pa1, pa2, pa3); pv_one<2>(o[2], vb, pa0, pa1, pa2, pa3); pv_one<3>(o[3], vb, pa0, pa1, pa2, pa3);
}

constexpr size_t SHM_X = 2 * SHM_V + 2 * SHM_K + NW * 64 * 4;
constexpr size_t SHM_ATTN_PP = SHM_X + 4 * 64 * 64 * 4;
__device__ __forceinline__ void qkt_c(f32x16& p0, f32x16& p1, const char* Ks, const bf16x8* qr, const f32x16& negm, int r32, int hi) {
#pragma unroll
  for (int d0 = 0; d0 < 4; ++d0) { const int cb = (d0 * 16 + hi * 8) * 2;
    bf16x8 b0 = *reinterpret_cast<const bf16x8*>(Ks + KSWZ(r32, cb));
    bf16x8 b1 = *reinterpret_cast<const bf16x8*>(Ks + KSWZ(32 + r32, cb));
    if (d0 == 0) { p0 = __builtin_amdgcn_mfma_f32_32x32x16_bf16(b0, qr[0], negm, 0, 0, 0); p1 = __builtin_amdgcn_mfma_f32_32x32x16_bf16(b1, qr[0], negm, 0, 0, 0); }
    else { p0 = __builtin_amdgcn_mfma_f32_32x32x16_bf16(b0, qr[d0], p0, 0, 0, 0); p1 = __builtin_amdgcn_mfma_f32_32x32x16_bf16(b1, qr[d0], p1, 0, 0, 0); } }
}
template <int R> __device__ __forceinline__ void bias_r(f32x16& p0, f32x16& p1, float dq, float nslope) {
  constexpr int C0 = (R & 3) + 8 * (R >> 2);
  float x0, x1, a0 = p0[R], a1 = p1[R];
  asm("v_sub_f32_e32 %0, %1, %2" : "=v"(x0) : "n"(__builtin_bit_cast(int, (float)C0)), "v"(dq));
  asm("v_sub_f32_e32 %0, %1, %2" : "=v"(x1) : "n"(__builtin_bit_cast(int, (float)(C0 + 32))), "v"(dq));
  asm("v_fma_f32 %0, %1, |%2|, %0" : "+v"(a0) : "v"(nslope), "v"(x0));
  asm("v_fma_f32 %0, %1, |%2|, %0" : "+v"(a1) : "v"(nslope), "v"(x1));
  p0[R] = a0; p1[R] = a1;
  if constexpr (R < 15) bias_r<R + 1>(p0, p1, dq, nslope);
}
__device__ __forceinline__ bool softmax_pp(f32x16& p0, f32x16& p1, float& m_reg, float& l_reg, f32x16& negm, float& alpha, float& m_run, float dq, float nslope,
                                           bf16x8& pa0, bf16x8& pa1, bf16x8& pa2, bf16x8& pa3) {
  bias_r<0>(p0, p1, dq, nslope);
  float a = fmaxf(fmaxf(p0[0], p0[1]), p1[0]), bq = fmaxf(fmaxf(p0[2], p0[3]), p1[1]); a = fmaxf(fmaxf(a, p1[2]), p1[3]);
#pragma unroll
  for (int r = 4; r < 16; r += 4) { a = fmaxf(fmaxf(a, p0[r]), p0[r + 1]); bq = fmaxf(fmaxf(bq, p0[r + 2]), p0[r + 3]); a = fmaxf(fmaxf(a, p1[r]), p1[r + 1]); bq = fmaxf(fmaxf(bq, p1[r + 2]), p1[r + 3]); }
  float pmax = fmaxf(a, bq);
  { auto rr = __builtin_amdgcn_permlane32_swap(__float_as_uint(pmax), __float_as_uint(pmax), false, false);
    pmax = fmaxf(__uint_as_float(rr[0]), __uint_as_float(rr[1])); }
  alpha = 1.f;
  { const float tmax = pmax + m_reg;
    if (__all(tmax < m_run - TSKIP)) return false;
    m_run = fmaxf(m_run, tmax); }
  if (__builtin_expect(!__all(pmax <= THRL), 0)) { const float dl = fmaxf(pmax, 0.f); m_reg += dl; alpha = __builtin_amdgcn_exp2f(-dl);
#pragma unroll
    for (int r = 0; r < 16; ++r) { p0[r] -= dl; p1[r] -= dl; }
#pragma unroll
    for (int r = 0; r < 16; ++r) negm[r] = -m_reg; }
#pragma unroll
  for (int r = 0; r < 16; ++r) { p0[r] = __builtin_amdgcn_exp2f(p0[r]); p1[r] = __builtin_amdgcn_exp2f(p1[r]); }
  float ps = 0;
#pragma unroll
  for (int r = 0; r < 16; ++r) ps += p0[r];
#pragma unroll
  for (int r = 0; r < 16; ++r) ps += p1[r];
  { auto rr = __builtin_amdgcn_permlane32_swap(__float_as_uint(ps), __float_as_uint(ps), false, false);
    ps = __uint_as_float(rr[0]) + __uint_as_float(rr[1]); }
  l_reg = l_reg * alpha + ps;
#define PK4(P, BASE, OUT) do { unsigned a0 = cvtpk(P[BASE + 0], P[BASE + 1]), a1 = cvtpk(P[BASE + 2], P[BASE + 3]);   \
    unsigned b0 = cvtpk(P[BASE + 4], P[BASE + 5]), b1 = cvtpk(P[BASE + 6], P[BASE + 7]);                              \
    auto r0 = __builtin_amdgcn_permlane32_swap(a0, b0, false, false); auto r1 = __builtin_amdgcn_permlane32_swap(a1, b1, false, false); \
    u32x4 w = {r0[0], r1[0], r0[1], r1[1]}; OUT = *reinterpret_cast<bf16x8*>(&w); } while (0)
  PK4(p0, 0, pa0); PK4(p0, 8, pa1); PK4(p1, 0, pa2); PK4(p1, 8, pa3);
#undef PK4
  return true;
}
__device__ __forceinline__ float sigm_(float x) { return __builtin_amdgcn_rcpf(1.0f + __builtin_amdgcn_exp2f(-1.4426950408889634f * x)); }
__device__ __forceinline__ void attn_unit_pp(int b, int h, int qb, int par, const bf16_t* __restrict__ QBp, const bf16_t* __restrict__ KBp, const bf16_t* __restrict__ VBp,
                                             const bf16_t* __restrict__ GBp, bf16_t* __restrict__ AOp, const bf16_t* __restrict__ PLDp, const bf16_t* __restrict__ WPLp, float lam, const float* __restrict__ sub_g, const unsigned* __restrict__ nrmk, char* lds) {
  int tid_ = threadIdx.x; asm volatile("" : "+v"(tid_));
  const int tid = tid_, wid = tid >> 6, lane = tid & 63, r32 = lane & 31, hi = lane >> 5, w4 = wid & 3, t256 = tid & 255;
  const int g = __builtin_amdgcn_readfirstlane(tid >> 8);
  const long rowbase = (long)b * SEQ; const int q0 = qb * 128;
  const size_t hoff = HEADMAJOR ? (size_t)(b * 8 + h) * SEQ * 128 : (size_t)b * SEQ * 1024 + h * 128;
  const bf16_t* Kh = KBp + hoff; const bf16_t* Vh = VBp + hoff;
  char* V_lds = lds; char* K_lds = lds + 2 * SHM_V;
  float* wsf = (float*)(lds + 2 * SHM_V + 2 * SHM_K) + wid * 64; float* li_l = wsf; float* al_l = wsf + 32;
  const float nslope = -exp2f(-(float)(h + 1)) * 1.4426950408889634f;
  const bf16_t* Qw = QBp + hoff + (size_t)(q0 + w4 * QBLK + r32) * LD + g * 64 + hi * 8;
  bf16x8 qr[4];
#pragma unroll
  for (int d0 = 0; d0 < 4; ++d0) qr[d0] = ld8(Qw + d0 * 16);
  const float qposf = (float)(q0 + w4 * QBLK + r32 - 4 * hi);
  const int sr = t256 >> 4, sc = (t256 & 15) * 8;
  int woff[4];
#pragma unroll
  for (int i = 0; i < 4; ++i) { const int row = sr + 16 * i; woff[i] = g ? (int)(2 * SHM_V) + KSWZ(row, sc * 2) : v_st(row, sc); }
  const bf16_t* Tsrc = (g ? Kh : Vh) + (long)sr * LD + sc;
  const char* Kmine = K_lds + g * 128;
  const int vb0 = (int)(uintptr_t)V_lds + v_rd_base(lane);
  float m_reg = 0.f, l_reg = 0.f, alpha = 1.f; f32x16 o[4]; f32x16 negm = f32x16{}; f32x16 p0, p1; bf16x8 pa0, pa1, pa2, pa3; bf16x8 stg[4];
#pragma unroll
  for (int d = 0; d < 4; ++d) o[d] = f32x16{};
  constexpr int NT = SEQ / KVBLK;
  float qn = 0.f;
#pragma unroll
  for (int d0 = 0; d0 < 4; ++d0) { const u32x4 w = __builtin_bit_cast(u32x4, qr[d0]);
#pragma unroll
    for (int e = 0; e < 4; ++e) { const float lo = __uint_as_float(w[e] << 16), hh = __uint_as_float(w[e] & 0xffff0000u); qn = fmaf(lo, lo, qn); qn = fmaf(hh, hh, qn); } }
  { auto rr = __builtin_amdgcn_permlane32_swap(__float_as_uint(qn), __float_as_uint(qn), false, false); qn = __uint_as_float(rr[0]) + __uint_as_float(rr[1]); }
  float sii = 0.f;
  { const bf16_t* Kw = Kh + (size_t)(q0 + w4 * QBLK + r32) * LD + g * 64 + hi * 8;
#pragma unroll
    for (int d0 = 0; d0 < 4; ++d0) { const u32x4 wq = __builtin_bit_cast(u32x4, qr[d0]); const u32x4 wk = __builtin_bit_cast(u32x4, ld8(Kw + d0 * 16));
#pragma unroll
      for (int e = 0; e < 4; ++e) { sii = fmaf(__uint_as_float(wq[e] << 16), __uint_as_float(wk[e] << 16), sii); sii = fmaf(__uint_as_float(wq[e] & 0xffff0000u), __uint_as_float(wk[e] & 0xffff0000u), sii); } } }
  { auto rr = __builtin_amdgcn_permlane32_swap(__float_as_uint(sii), __float_as_uint(sii), false, false); sii = __uint_as_float(rr[0]) + __uint_as_float(rr[1]); }
  { const unsigned* nk = nrmk + ((size_t)((b * 8 + h) * 2 + g)) * 2; const float kn = __uint_as_float(__hip_atomic_load(nk, __ATOMIC_RELAXED, __HIP_MEMORY_SCOPE_AGENT)) + __uint_as_float(__hip_atomic_load(nk + 1, __ATOMIC_RELAXED, __HIP_MEMORY_SCOPE_AGENT));
    qn = sqrtf(qn * kn) * 1.02f - sii; }
#pragma unroll
  for (int x = 1; x < 32; x <<= 1) qn = fmaxf(qn, __builtin_bit_cast(float, __builtin_amdgcn_ds_bpermute((lane ^ x) << 2, __builtin_bit_cast(int, qn))));
  float* xb = (float*)(lds + 143360 + 128) + par * 16;
  if (lane == 0) xb[wid] = qn;
  __syncthreads();
  float Bq = 0.f;
#pragma unroll
  for (int i = 0; i < 8; ++i) Bq = fmaxf(Bq, xb[i]);
  int jlo, n;
  { const float dmax = (TSKIP + Bq + 0.05f) / (-nslope);
    const float klo = (float)q0 - dmax, khi = (float)(q0 + 127) + dmax;
    int a0 = klo <= 0.f ? 0 : (int)(klo * (1.f / 64.f)); int a1 = khi >= (float)(SEQ - 1) ? NT - 1 : (int)(khi * (1.f / 64.f));
    if (((a1 - a0 + 1) & 1) != 0) { if (a0 > 0) --a0; else ++a1; }
    jlo = __builtin_amdgcn_readfirstlane(a0); n = __builtin_amdgcn_readfirstlane(a1 - a0 + 1); }
  const int dt = 2 * qb, nR = jlo + n - dt;
#define TILE(jj) ((jj) < nR ? dt + (jj) : dt - 1 - ((jj) - nR))
  float m_run = -1e30f; int live = 0;
#pragma unroll
  for (int i = 0; i < 4; ++i) stg[i] = ld8(Kh + (long)(TILE(g) * KVBLK + sr + 16 * i) * LD + sc);
#pragma unroll
  for (int i = 0; i < 4; ++i) *(bf16x8*)(K_lds + g * SHM_K + KSWZ(sr + 16 * i, sc * 2)) = stg[i];
  if (!g || n > 2) {
#pragma unroll
    for (int i = 0; i < 4; ++i) stg[i] = ld8(Tsrc + (long)(TILE(g ? 2 : 0) * KVBLK + 16 * i) * LD); }
  __syncthreads();
  if (g == 1) { __builtin_amdgcn_s_setprio(1); __syncthreads(); }
#define RESC_() do { if (__any(alpha < 1.f)) { if (hi == 0) al_l[r32] = alpha; asm volatile("s_waitcnt lgkmcnt(0)" ::: "memory"); \
    _Pragma("unroll") for (int d = 0; d < 4; ++d) _Pragma("unroll") for (int r = 0; r < 16; ++r) o[d][r] *= al_l[crow(r, hi)]; } } while (0)
#define PP_STEP(j, PAR) do { \
    qkt_c(p0, p1, Kmine + (PAR) * SHM_K, qr, negm, r32, hi); \
    if (live) pv_d0(o, vb0 + (1 - (PAR)) * (int)SHM_V, pa0, pa1, pa2, pa3); \
    __syncthreads(); \
    live = __builtin_amdgcn_readfirstlane((int)softmax_pp(p0, p1, m_reg, l_reg, negm, alpha, m_run, qposf - (float)(TILE(j) * KVBLK), nslope, pa0, pa1, pa2, pa3)); \
    RESC_(); \
    { const int wt = g ? (j) + 2 : (j); \
      if (wt < n) { _Pragma("unroll") for (int i = 0; i < 4; ++i) *(bf16x8*)(lds + woff[i] + (PAR) * 16384) = stg[i]; } \
      if (wt + 1 < n) { const int tn = TILE(wt + 1); _Pragma("unroll") for (int i = 0; i < 4; ++i) stg[i] = ld8(Tsrc + (long)(tn * KVBLK + 16 * i) * LD); } } \
    __syncthreads(); } while (0)
  _Pragma("nounroll") for (int j = 0; j < n; j += 2) { PP_STEP(j, 0); PP_STEP(j + 1, 1); }
  if (live) pv_d0(o, vb0 + (int)SHM_V, pa0, pa1, pa2, pa3);
  if (g == 0) __syncthreads();
  __builtin_amdgcn_s_setprio(0);
#undef PP_STEP
#undef RESC_
#undef TILE
  if (hi == 0) li_l[r32] = l_reg; asm volatile("s_waitcnt lgkmcnt(0)" ::: "memory");
#pragma unroll
  for (int r = 0; r < 16; ++r) { const float rl = __builtin_amdgcn_rcpf(li_l[crow(r, hi)]);
#pragma unroll
    for (int d0 = 0; d0 < 4; ++d0) o[d0][r] *= rl; }
  float* xs = (float*)(lds + SHM_X) + w4 * 4096 + lane;
  const size_t row0 = (size_t)(rowbase + q0 + w4 * QBLK + 4 * hi);
  unsigned gofs = (unsigned)((row0 * 2048 + h * 128 + r32) * 2), aofs = (unsigned)((row0 * 1024 + h * 128 + r32) * 2);
  asm volatile("" : "+v"(gofs), "+v"(aofs));
#define GATE_LD(ro_, col_) (*(const unsigned short*)((const char*)GBp + (gofs + (unsigned)(((ro_) * 2048 + (col_)) * 2))))
#define MIX_ST(ro_, col_, v_) (*(unsigned short*)((char*)AOp + (aofs + (unsigned)(((ro_) * 1024 + (col_)) * 2))) = (v_))
  float* pgs = (float*)lds + w4 * 4096 + lane;
  if (g == 1) {
    unsigned gate16[64];
#pragma unroll
    for (int r = 0; r < 16; ++r)
#pragma unroll
      for (int d0 = 0; d0 < 4; ++d0) gate16[r * 4 + d0] = GATE_LD((r & 3) + 8 * (r >> 2), 1024 + d0 * 32);
    bf16x8 pf[8];
    { const bf16_t* pr = PLDp + (size_t)(rowbase + q0 + w4 * QBLK + r32) * 512 + (h >> 1) * 128 + hi * 8;
#pragma unroll
      for (int ks = 0; ks < 8; ++ks) pf[ks] = ld8(pr + ks * 16); }
#pragma unroll
    for (int d0 = 0; d0 < 4; ++d0)
#pragma unroll
      for (int r = 0; r < 16; ++r) xs[(d0 * 16 + r) * 64] = o[d0][r];
    __syncthreads();
    const bf16_t* wpb = WPLp + (size_t)((h >> 1) * 256 + (h & 1) * 128 + r32) * 128 + hi * 8;
#pragma unroll
    for (int dp = 0; dp < 2; ++dp) {
      bf16x8 wp[2][8];
#pragma unroll
      for (int e = 0; e < 2; ++e)
#pragma unroll
        for (int ks = 0; ks < 8; ++ks) wp[e][ks] = ld8(wpb + (dp * 2 + e) * 32 * 128 + ks * 16);
#pragma unroll
      for (int e = 0; e < 2; ++e) { const int d0 = dp * 2 + e; f32x16 acc = f32x16{};
#pragma unroll
        for (int ks = 0; ks < 8; ++ks) acc = __builtin_amdgcn_mfma_f32_32x32x16_bf16(pf[ks], wp[e][ks], acc, 0, 0, 0);
#pragma unroll
        for (int r = 0; r < 16; ++r) pgs[(d0 * 16 + r) * 64] = sigm_(__uint_as_float(gate16[r * 4 + d0] << 16)) * acc[r]; }
    }
    __syncthreads();
  } else {
    unsigned gate16[64];
#pragma unroll
    for (int r = 0; r < 16; ++r)
#pragma unroll
      for (int d0 = 0; d0 < 4; ++d0) gate16[r * 4 + d0] = GATE_LD((r & 3) + 8 * (r >> 2), d0 * 32);
    __syncthreads();
    float ss[16];
#pragma unroll
    for (int r = 0; r < 16; ++r) ss[r] = 0.f;
#pragma unroll
    for (int d0 = 0; d0 < 4; ++d0)
#pragma unroll
      for (int r = 0; r < 16; ++r) { const float v = o[d0][r] - lam * xs[(d0 * 16 + r) * 64]; o[d0][r] = v; ss[r] += v * v; }
#pragma unroll
    for (int r = 0; r < 16; ++r) { float s = ss[r];
#pragma unroll
      for (int x = 1; x < 32; x <<= 1) s += __builtin_bit_cast(float, __builtin_amdgcn_ds_bpermute((lane ^ x) << 2, __builtin_bit_cast(int, s)));
      ss[r] = 1.0f / sqrtf(s * (1.0f / 128.0f) + 1e-5f); }
    float sg[4];
#pragma unroll
    for (int d0 = 0; d0 < 4; ++d0) sg[d0] = sub_g[d0 * 32 + r32] * 0.8f;
#pragma unroll
    for (int r = 0; r < 16; ++r)
#pragma unroll
      for (int d0 = 0; d0 < 4; ++d0) { const float ga = __uint_as_float(gate16[r * 4 + d0] << 16); o[d0][r] = o[d0][r] * ss[r] * sg[d0] * sigm_(ga); }
    __syncthreads();
#pragma unroll
    for (int d0 = 0; d0 < 4; ++d0)
#pragma unroll
      for (int r = 0; r < 16; ++r) { const int ro = (r & 3) + 8 * (r >> 2);
        const float val = o[d0][r] + pgs[(d0 * 16 + r) * 64];
        unsigned u = __float_as_uint(val); u = (u + 0x7fffu + ((u >> 16) & 1u)) >> 16;
        MIX_ST(ro, d0 * 32, (unsigned short)u); }
  }
#undef GATE_LD
#undef MIX_ST
}
#undef SBAR
}

#define GAS __attribute__((address_space(1)))
#define LAS __attribute__((address_space(3)))
typedef unsigned short bf16;
typedef unsigned v4u __attribute__((ext_vector_type(4)));
typedef float f32x4 __attribute__((ext_vector_type(4)));
constexpr int NWAVES = 8;
constexpr size_t MiB = 1u << 20;
constexpr size_t WS_MOD = 1 * MiB;
constexpr size_t WS_MODP = 2 * MiB;
constexpr size_t WS_WIN = 14 * MiB;
constexpr size_t WS_WOUT = 25 * MiB;
constexpr size_t WS_WF1 = 27 * MiB;
constexpr size_t WS_WF2 = 38 * MiB;
constexpr size_t WS_WPL = 44 * MiB;
constexpr size_t WS_H = 80 * MiB;
constexpr size_t WS_PLD = 208 * MiB;
constexpr size_t WS_Q = 272 * MiB, WS_K = 400 * MiB, WS_V = 528 * MiB, WS_U = 656 * MiB, WS_G = 720 * MiB;
constexpr size_t WS_ACT = 272 * MiB;
constexpr size_t WS_END = 976 * MiB;
constexpr int LDS_BYTES = 147456;

#define LDS_WAIT() asm volatile("s_waitcnt lgkmcnt(0)" ::: "memory")
__device__ __forceinline__ unsigned f2bf(float f) { unsigned u = __builtin_bit_cast(unsigned, f); return (u + 0x7fffu + ((u >> 16) & 1u)) >> 16; }
__device__ __forceinline__ unsigned pk2(float lo, float hi) { return f2bf(lo) | (f2bf(hi) << 16); }
__device__ __forceinline__ float wave_sum(float v, int lane) {
#pragma unroll
    for (int o = 1; o < 64; o <<= 1) v += __builtin_bit_cast(float, __builtin_amdgcn_ds_bpermute((lane ^ o) << 2, __builtin_bit_cast(int, v)));
    return v;
}
__device__ __forceinline__ void p0_transpose_item(const float* W, int K, int N, bf16* WT, int mode, LAS float* scr, int item, int lane, const float* nscale = nullptr) {
    const int nblk = N / 32, kb = item / nblk, nb = item % nblk, k0 = 64 * kb, n0 = 32 * nb;
    int d0 = n0;
    if (mode == 1) { d0 = (n0 < DFF) ? (256 * (n0 >> 7) + (n0 & 127)) : (256 * ((n0 - DFF) >> 7) + 128 + ((n0 - DFF) & 127)); }
    const float nsc = nscale ? nscale[n0 + (lane & 31)] : 1.0f;
    float wv[32];
#pragma unroll
    for (int i = 0; i < 32; ++i) { const int kk = 2 * i + (lane >> 5); wv[i] = __builtin_nontemporal_load(&W[(size_t)(k0 + kk) * N + n0 + (lane & 31)]); }
#pragma unroll
    for (int i = 0; i < 32; ++i) { const int kk = 2 * i + (lane >> 5); scr[kk * 33 + (lane & 31)] = wv[i] * nsc; }
    LDS_WAIT(); asm volatile("" ::: "memory");
    const int c = lane & 7;
#pragma unroll
    for (int j = 0; j < 4; ++j) { const int n = (lane >> 3) + 8 * j; const LAS float* s = scr + (8 * c) * 33 + n;
        v4u o; o.x = pk2(s[0 * 33], s[1 * 33]); o.y = pk2(s[2 * 33], s[3 * 33]); o.z = pk2(s[4 * 33], s[5 * 33]); o.w = pk2(s[6 * 33], s[7 * 33]);
        *(GAS v4u*)(WT + (size_t)(d0 + n) * K + k0 + 8 * c) = o; }
    LDS_WAIT(); asm volatile("" ::: "memory");
}
__device__ __forceinline__ void p0_mod_item(const float* c, const float* w_ada, float* part, LAS float* scr, int item, int lane) {
    const int cgp = item % 96, kc = item / 96, j = cgp * 64 + lane, k0 = kc * 64;
    { float cv[32];
#pragma unroll
      for (int b = 0; b < 32; ++b) cv[b] = c[b * 1024 + k0 + lane];
#pragma unroll
      for (int b = 0; b < 32; ++b) scr[b * 64 + lane] = cv[b] / (1.0f + __expf(-cv[b])); }
    LDS_WAIT(); asm volatile("" ::: "memory");
    float acc[32];
#pragma unroll
    for (int b = 0; b < 32; ++b) acc[b] = 0.f;
    for (int kk = 0; kk < 64; kk += 8) {
        float w[8];
#pragma unroll
        for (int i = 0; i < 8; ++i) w[i] = __builtin_nontemporal_load(&w_ada[(size_t)(k0 + kk + i) * NMOD + j]);
#pragma unroll
        for (int b = 0; b < 32; ++b) { const f32x4 s0 = *(const LAS f32x4*)(scr + b * 64 + kk), s1 = *(const LAS f32x4*)(scr + b * 64 + kk + 4);
            acc[b] += (s0.x * w[0] + s0.y * w[1] + s0.z * w[2] + s0.w * w[3]) + (s1.x * w[4] + s1.y * w[5] + s1.z * w[6] + s1.w * w[7]); }
    }
#pragma unroll
    for (int b = 0; b < 32; ++b) part[(size_t)(kc * 32 + b) * NMOD + j] = acc[b];
    LDS_WAIT(); asm volatile("" ::: "memory");
}

#define XB_TMO      128
#define XB_XCNT(j)  (256  + 64 * (j))
#define XB_XSUB(j)  (1280 + 64 * (j))
#define XB_XGEN(j)  (2304 + 64 * (j))
#define XB_TOP      3328
#define XB_TOPGEN   3392
#define XCD_BAR_WORDS 3456
#define XB_SPIN_CAP (1u << 18)

__device__ __forceinline__ unsigned xb_ld(unsigned* p)              { return __hip_atomic_load(p, __ATOMIC_RELAXED, __HIP_MEMORY_SCOPE_AGENT); }
__device__ __forceinline__ unsigned xb_add(unsigned* p, unsigned v) { return __hip_atomic_fetch_add(p, v, __ATOMIC_RELAXED, __HIP_MEMORY_SCOPE_AGENT); }
__device__ __forceinline__ unsigned xb_xcc_id() { return (unsigned)__builtin_amdgcn_s_getreg((3 << 11) | 20) & 0xFu; }
#define XB_SPIN(cond, bar) do { unsigned _sp = 0; while (cond) { __builtin_amdgcn_s_sleep(1); \
    if ((++_sp & 255u) == 0u) { if (xb_ld(&(bar)[XB_TMO])) break; if (_sp > XB_SPIN_CAP) { atomicAdd(&(bar)[XB_TMO], 1u); break; } } } } while (0)

struct XcdBarrier {
    unsigned* bar; unsigned x;
    volatile LAS unsigned* st;
};

__device__ __forceinline__ XcdBarrier xcd_barrier_post(unsigned* bar, volatile LAS unsigned* st) {
    XcdBarrier b; b.bar = bar; b.x = xb_xcc_id(); b.st = st;
    if (threadIdx.x == 0) (void)xb_add(&bar[XB_XCNT(b.x)], 1u);
    return b;
}
__device__ __forceinline__ void xcd_barrier_complete(unsigned* bar, unsigned x, unsigned& nloc, unsigned& nx) {
    const unsigned G = gridDim.x * gridDim.y * gridDim.z;
    unsigned sum, cnt, mine, sp = 0u;
    for (;;) {
        sum = 0u; cnt = 0u; mine = 0u;
#pragma unroll
        for (unsigned j = 0; j < 16; ++j) { const unsigned c = xb_ld(&bar[XB_XCNT(j)]); sum += c; cnt += (c > 0u) ? 1u : 0u; mine = (j == x) ? c : mine; }
        if (sum == G) break;
        __builtin_amdgcn_s_sleep(1);
        if ((++sp & 255u) == 0u) { if (xb_ld(&bar[XB_TMO])) break; if (sp > XB_SPIN_CAP) { atomicAdd(&bar[XB_TMO], 1u); break; } }
    }
    nloc = mine > 0u ? mine : 1u; nx = cnt > 0u ? cnt : 1u;
}

__device__ __forceinline__ void xcd_barrier(const XcdBarrier& b) {
    asm volatile("s_waitcnt vmcnt(0)" ::: "memory");
    __syncthreads();
    if (threadIdx.x == 0) {
        unsigned* bar = b.bar;
        __builtin_amdgcn_s_waitcnt(0);
        unsigned nloc = b.st[0], nx = b.st[1];
        if (nloc == 0u) { xcd_barrier_complete(bar, b.x, nloc, nx); b.st[0] = nloc; b.st[1] = nx; }
        const unsigned old = xb_add(&bar[XB_XSUB(b.x)], 1u);
        const unsigned gen = old / nloc;
        if (old + 1u == (gen + 1u) * nloc) {
            __builtin_amdgcn_fence(__ATOMIC_RELEASE, "agent");
            asm volatile("s_waitcnt vmcnt(0)" ::: "memory");
            const unsigned og = xb_add(&bar[XB_TOP], 1u);
            const unsigned tg = og / nx;
            if (og + 1u == (tg + 1u) * nx) xb_add(&bar[XB_TOPGEN], 1u);
            else XB_SPIN(xb_ld(&bar[XB_TOPGEN]) == tg, bar);
            __builtin_amdgcn_fence(__ATOMIC_ACQUIRE, "agent");
            xb_add(&bar[XB_XGEN(b.x)], 1u);
            asm volatile("s_waitcnt vmcnt(0)" ::: "memory");
        } else {
            XB_SPIN(xb_ld(&bar[XB_XGEN(b.x)]) == gen, bar);
            __builtin_amdgcn_fence(__ATOMIC_ACQUIRE, "agent");
            asm volatile("s_waitcnt vmcnt(0)" ::: "memory");
        }
    }
    __syncthreads();
}

struct Args { const float* in[19]; float* out; unsigned char* ws; };
#define PHASE_IDS int t__ = threadIdx.x; asm volatile("" : "+v"(t__)); const int tid = t__, lane = tid & 63, wave = __builtin_amdgcn_readfirstlane(tid >> 6), gw = vcu * NWAVES + wave; (void)tid; (void)lane; (void)wave; (void)gw

__global__ void __launch_bounds__(NWAVES * 64) mega_fwd(Args args) {
    extern __shared__ __attribute__((aligned(16))) unsigned char lds[];
    cg::grid_group grid = cg::this_grid();
    const int tid = threadIdx.x, lane = tid & 63, wave = __builtin_amdgcn_readfirstlane(tid >> 6);
    const int G = gridDim.x, bx = blockIdx.x; int vcu = bx, gc = bx;
    const int NGW = G * NWAVES;
    unsigned char* ws = args.ws;
    unsigned* ctl = (unsigned*)ws;
    volatile LAS unsigned* misc = (volatile LAS unsigned*)((LAS unsigned char*)lds + 143360);
    if (tid < 16) misc[tid] = 0u;
    __syncthreads();
    const XcdBarrier xbar = xcd_barrier_post((unsigned*)(ws + 16384), misc + 8);
    if (tid == 0) { const unsigned xcc = (unsigned)__builtin_amdgcn_s_getreg((3 << 11) | 20) & 0xFu;
        misc[0] = xcc; misc[1] = __hip_atomic_fetch_add(ctl + 64 * xcc, 1u, __ATOMIC_RELAXED, __HIP_MEMORY_SCOPE_AGENT); }
    const float* x = args.in[0]; const float* cvec = args.in[1]; const float* w_ada = args.in[2]; const float* b_ada = args.in[3]; const float* w_in = args.in[4];
    const float* lq1 = args.in[5]; const float* lk1 = args.in[6]; const float* lq2 = args.in[7]; const float* lk2 = args.in[8]; const float* sub_g = args.in[9];
    const float* w_pool = args.in[10]; const float* pool_scale = args.in[11]; const float* w_out = args.in[12]; const float* ln1_g = args.in[13]; const float* ln1_b = args.in[14];
    const float* w_f1 = args.in[15]; const float* w_f2 = args.in[16]; const float* ln2_g = args.in[17]; const float* ln2_b = args.in[18];
    float* out = args.out;
    float* MOD = (float*)(ws + WS_MOD); float* MODP = (float*)(ws + WS_MODP);
    bf16* Wt_in = (bf16*)(ws + WS_WIN); bf16* Wt_out = (bf16*)(ws + WS_WOUT); bf16* Wt_f1 = (bf16*)(ws + WS_WF1); bf16* Wt_f2 = (bf16*)(ws + WS_WF2); bf16* Wt_pl = (bf16*)(ws + WS_WPL);
    bf16* HB = (bf16*)(ws + WS_H); bf16* PLD = (bf16*)(ws + WS_PLD);
    bf16* QB = (bf16*)(ws + WS_Q); bf16* KB = (bf16*)(ws + WS_K); bf16* VB = (bf16*)(ws + WS_V); bf16* UB = (bf16*)(ws + WS_U); bf16* GB = (bf16*)(ws + WS_G);
    bf16* ACT = (bf16*)(ws + WS_ACT);
    bf16* Y1 = (bf16*)(ws + WS_Q); bf16* Y2 = (bf16*)(ws + WS_G);
    unsigned* NRMK = (unsigned*)(ws + 8192);

    {
        PHASE_IDS;
        LAS float* scr = (LAS float*)((LAS unsigned char*)lds + wave * 16384);
        constexpr int I_IN = 16 * 176, I_OUT = 16 * 32, I_F1 = 16 * 176, I_F2 = 44 * 32, I_PL = 64, I_MOD = 96 * 16;
        constexpr int NITEMS = I_IN + I_OUT + I_F1 + I_F2 + I_PL + I_MOD;
        for (int it = gw; it < NITEMS; it += NGW) {
            int r = it;
            if (r < I_MOD) { p0_mod_item(cvec, w_ada, MODP, scr, r, lane); continue; } r -= I_MOD;
            if (r < I_IN) { p0_transpose_item(w_in, D, INC, Wt_in, 0, scr, r, lane); continue; } r -= I_IN;
            if (r < I_OUT) { p0_transpose_item(w_out, D, D, Wt_out, 0, scr, r, lane); continue; } r -= I_OUT;
            if (r < I_F1) { p0_transpose_item(w_f1, D, 2 * DFF, Wt_f1, 1, scr, r, lane); continue; } r -= I_F1;
            if (r < I_F2) { p0_transpose_item(w_f2, DFF, D, Wt_f2, 0, scr, r, lane); continue; } r -= I_F2;
            { const int g = r >> 4; p0_transpose_item(w_pool + (size_t)g * 128 * 256, 128, 256, Wt_pl + (size_t)g * 256 * 128, 0, scr, r & 15, lane, pool_scale + g * 256); }
        }
    }
    if (gridDim.y > 1) grid.sync();
    xcd_barrier(xbar);
    {
        if (threadIdx.x < 64) {
            const unsigned l_ = threadIdx.x, cj = l_ < 16u ? __hip_atomic_load(ctl + 64 * l_, __ATOMIC_RELAXED, __HIP_MEMORY_SCOPE_AGENT) : 0u;
            const unsigned xcc = misc[0], rank = misc[1]; unsigned pre = 0; bool even8 = true;
#pragma unroll
            for (int j = 0; j < 16; ++j) { const unsigned c_ = (unsigned)__builtin_amdgcn_readlane((int)cj, j);
                if ((unsigned)j < xcc) pre += c_; if (j < 8 ? (c_ * 8u != (unsigned)G) : (c_ != 0u)) even8 = false; }
            if (l_ == 0) { misc[2] = pre + rank; misc[3] = even8 ? rank * 8u + xcc : (unsigned)bx; } }
        __syncthreads();
        vcu = (int)misc[2]; gc = (int)misc[3];
        vcu = __builtin_amdgcn_readfirstlane(vcu); gc = __builtin_amdgcn_readfirstlane(gc);
    }

    {
        PHASE_IDS;
        LAS float* shsc = (LAS float*)lds;
        for (int p = vcu; p < MROWS / 256; p += G) {
            const int b = p >> 3, k8 = p & 7;
            __syncthreads();
            { float sv[5];
#pragma unroll
              for (int i = 0; i < 5; ++i) { const int j = tid + i * NWAVES * 64; const int col = j < 2048 ? j : 2048 + 512 * k8 + (j - 2048); float s = b_ada[col];
#pragma unroll
                  for (int kc = 0; kc < 16; ++kc) s += MODP[(size_t)(kc * 32 + b) * NMOD + col];
                  sv[i] = s; }
#pragma unroll
              for (int i = 0; i < 5; ++i) { const int j = tid + i * NWAVES * 64; const int col = j < 2048 ? j : 2048 + 512 * k8 + (j - 2048);
                  if (j < 2048) shsc[j] = sv[i]; else MOD[(size_t)b * NMOD + col] = sv[i]; } }
            __syncthreads();
            for (int rr = wave; rr < 256; rr += NWAVES) {
                const size_t row = (size_t)p * 256 + rr;
                const GAS f32x4* xr = (const GAS f32x4*)(x + row * D) + lane;
                f32x4 v[4]; float s = 0.f;
#pragma unroll
                for (int j = 0; j < 4; ++j) { v[j] = __builtin_nontemporal_load(&xr[64 * j]); s += (v[j].x + v[j].y) + (v[j].z + v[j].w); }
                const float mean = wave_sum(s, lane) * (1.f / D); float s2 = 0.f;
#pragma unroll
                for (int j = 0; j < 4; ++j) { v[j] = v[j] - mean; s2 += (v[j].x * v[j].x + v[j].y * v[j].y) + (v[j].z * v[j].z + v[j].w * v[j].w); }
                const float rstd = 1.f / sqrtf(wave_sum(s2, lane) * (1.f / D) + LN_EPS);
                GAS unsigned long long* o8 = (GAS unsigned long long*)(HB + row * D) + lane;
#pragma unroll
                for (int j = 0; j < 4; ++j) { const f32x4 sh = *(const LAS f32x4*)(shsc + 256 * j + 4 * lane), sc = *(const LAS f32x4*)(shsc + 1024 + 256 * j + 4 * lane);
                    const f32x4 y = v[j] * rstd * (sc + 1.0f) + sh;
                    o8[64 * j] = (unsigned long long)pk2(y.x, y.y) | ((unsigned long long)pk2(y.z, y.w) << 32); }
            }
        }
    }
    xcd_barrier(xbar);

    {
        PHASE_IDS;
        pg8::Gemm g{HB, Wt_in, MROWS, INC, D, D, D, 0}; pg8::StaticOrder S; S.init(MROWS, INC, G, gc);
        pg8::EpiProj E{QB, KB, VB, UB, GB, QSCALE, NRMK};
        pg8::gemm_phase<pg8::EpiProj, pg8::StaticOrder, true, true>((LAS unsigned char*)lds, g, S, E);
    }
    xcd_barrier(xbar);

    {
        PHASE_IDS;
        for (int chunk = gw; chunk < MROWS / 32; chunk += NGW) {
            const int row0 = chunk * 32, t0 = row0 & (SEQ - 1), gi = lane >> 4, half = 1 << gi;
            const bf16* base = UB + (size_t)(row0 - t0) * PIN + lane * 8;
            float s[8];
#pragma unroll
            for (int e = 0; e < 8; ++e) s[e] = 0.f;
#define ACC_ROW(tau, sgn) do { const v4u w_ = *(const v4u*)(base + (size_t)(tau) * PIN); \
                s[0] += (sgn) * pg8::bf_lo(w_.x); s[1] += (sgn) * pg8::bf_hi(w_.x); s[2] += (sgn) * pg8::bf_lo(w_.y); s[3] += (sgn) * pg8::bf_hi(w_.y); \
                s[4] += (sgn) * pg8::bf_lo(w_.z); s[5] += (sgn) * pg8::bf_hi(w_.z); s[6] += (sgn) * pg8::bf_lo(w_.w); s[7] += (sgn) * pg8::bf_hi(w_.w); } while (0)
            { const int lo = (t0 - half) > 0 ? (t0 - half) : 0, hi = (t0 + half) < SEQ ? (t0 + half) : SEQ;
              v4u w16[16];
#pragma unroll
              for (int q = 0; q < 16; ++q) w16[q] = *(const v4u*)(base + (size_t)((lo + q) < hi ? (lo + q) : lo) * PIN);
#pragma unroll
              for (int q = 0; q < 16; ++q) { const float m_ = (lo + q) < hi ? 1.0f : 0.0f; const v4u a_ = w16[q];
                  s[0] += m_ * pg8::bf_lo(a_.x); s[1] += m_ * pg8::bf_hi(a_.x); s[2] += m_ * pg8::bf_lo(a_.y); s[3] += m_ * pg8::bf_hi(a_.y);
                  s[4] += m_ * pg8::bf_lo(a_.z); s[5] += m_ * pg8::bf_hi(a_.z); s[6] += m_ * pg8::bf_lo(a_.w); s[7] += m_ * pg8::bf_hi(a_.w); } }
            for (int tt = 0; tt < 32; tt += 4) {
                v4u ut[4], wa[4], wr[4]; float ma[4], mr[4];
#pragma unroll
                for (int q = 0; q < 4; ++q) { const int t = t0 + tt + q, ta = t + half, tr = t - half;
                    ut[q] = *(const v4u*)(base + (size_t)t * PIN);
                    ma[q] = ta < SEQ ? 1.0f : 0.0f; wa[q] = *(const v4u*)(base + (size_t)(ta < SEQ ? ta : SEQ - 1) * PIN);
                    mr[q] = tr >= 0 ? -1.0f : 0.0f; wr[q] = *(const v4u*)(base + (size_t)(tr >= 0 ? tr : 0) * PIN); }
#pragma unroll
                for (int q = 0; q < 4; ++q) { const int t = t0 + tt + q, lo = (t - half) > 0 ? (t - half) : 0, hi = (t + half) < SEQ ? (t + half) : SEQ;
                    const float inv = 1.0f / (float)(hi - lo); const v4u u_ = ut[q];
                    v4u o; o.x = pk2(s[0] * inv - pg8::bf_lo(u_.x), s[1] * inv - pg8::bf_hi(u_.x)); o.y = pk2(s[2] * inv - pg8::bf_lo(u_.y), s[3] * inv - pg8::bf_hi(u_.y));
                    o.z = pk2(s[4] * inv - pg8::bf_lo(u_.z), s[5] * inv - pg8::bf_hi(u_.z)); o.w = pk2(s[6] * inv - pg8::bf_lo(u_.w), s[7] * inv - pg8::bf_hi(u_.w));
                    __builtin_nontemporal_store(o, (v4u*)(PLD + (size_t)(row0 + tt + q) * PIN + lane * 8));
                    { const v4u a_ = wa[q]; const float m_ = ma[q];
                      s[0] += m_ * pg8::bf_lo(a_.x); s[1] += m_ * pg8::bf_hi(a_.x); s[2] += m_ * pg8::bf_lo(a_.y); s[3] += m_ * pg8::bf_hi(a_.y);
                      s[4] += m_ * pg8::bf_lo(a_.z); s[5] += m_ * pg8::bf_hi(a_.z); s[6] += m_ * pg8::bf_lo(a_.w); s[7] += m_ * pg8::bf_hi(a_.w); }
                    { const v4u r_ = wr[q]; const float m_ = mr[q];
                      s[0] += m_ * pg8::bf_lo(r_.x); s[1] += m_ * pg8::bf_hi(r_.x); s[2] += m_ * pg8::bf_lo(r_.y); s[3] += m_ * pg8::bf_hi(r_.y);
                      s[4] += m_ * pg8::bf_lo(r_.z); s[5] += m_ * pg8::bf_hi(r_.z); s[6] += m_ * pg8::bf_lo(r_.w); s[7] += m_ * pg8::bf_hi(r_.w); } }
            }
#undef ACC_ROW
        }
        xcd_barrier(xbar);
        const float lam = __expf(wave_sum(lq1[lane] * lk1[lane], lane)) - __expf(wave_sum(lq2[lane] * lk2[lane], lane)) + 0.2f;
        for (int i = 0, U = vcu; U < BATCH * NH * (SEQ / 128); U += G, ++i) {
            int b = U >> 7, h = (U >> 4) & 7, qb = U & 15;
            if (G == 256) { const int gi = vcu >> 4; h = (gi + i) & 7; b = i * 2 + (gi >> 3); qb = (vcu + i) & 15; }
            attn::attn_unit_pp(b, h, qb, i & 1, QB, KB, VB, GB, HB, PLD, Wt_pl, lam, sub_g, NRMK, (char*)lds);
        }
        __syncthreads();
    }
    xcd_barrier(xbar);

    {
        PHASE_IDS;
        pg8::Gemm g{HB, Wt_out, MROWS, D, D, D, D, 0}; pg8::StaticOrder S; S.init(MROWS, D, G, gc);
        pg8::EpiGate E{Y1, MOD + 2048};
        pg8::gemm_phase<pg8::EpiGate, pg8::StaticOrder, true, true>((LAS unsigned char*)lds, g, S, E);
    }
    xcd_barrier(xbar);

    {
        PHASE_IDS;
        f32x4 g1v[4], b1v[4];
#pragma unroll
        for (int j = 0; j < 4; ++j) { g1v[j] = *(const f32x4*)(ln1_g + 256 * j + 4 * lane); b1v[j] = *(const f32x4*)(ln1_b + 256 * j + 4 * lane); }
    for (int row = gw; row < MROWS; row += NGW) {
        const int b = row >> 11; const float* mb = MOD + (size_t)b * NMOD;
        GAS f32x4* zr = (GAS f32x4*)(out + (size_t)row * D) + lane;
        const GAS f32x4* xr = (const GAS f32x4*)(x + (size_t)row * D) + lane;
        const GAS unsigned long long* yr = (const GAS unsigned long long*)(Y1 + (size_t)row * D) + lane;
        f32x4 v[4]; float s = 0.f;
#pragma unroll
        for (int j = 0; j < 4; ++j) { const f32x4 xv = __builtin_nontemporal_load(&xr[64 * j]); const unsigned long long yy = __builtin_nontemporal_load(&yr[64 * j]); const unsigned ylo = (unsigned)yy, yhi = (unsigned)(yy >> 32);
            v[j] = xv * ALPHA + (f32x4){pg8::bf_lo(ylo), pg8::bf_hi(ylo), pg8::bf_lo(yhi), pg8::bf_hi(yhi)};
            s += (v[j].x + v[j].y) + (v[j].z + v[j].w); }
        float mean = wave_sum(s, lane) * (1.f / D), s2 = 0.f;
#pragma unroll
        for (int j = 0; j < 4; ++j) { v[j] = v[j] - mean; s2 += (v[j].x * v[j].x + v[j].y * v[j].y) + (v[j].z * v[j].z + v[j].w * v[j].w); }
        float rstd = 1.f / sqrtf(wave_sum(s2, lane) * (1.f / D) + LN_EPS);
        s = 0.f;
#pragma unroll
        for (int j = 0; j < 4; ++j) { const f32x4 gg = g1v[j], bb = b1v[j];
            v[j] = v[j] * rstd * gg + bb; __builtin_nontemporal_store(v[j], &zr[64 * j]); s += (v[j].x + v[j].y) + (v[j].z + v[j].w); }
        mean = wave_sum(s, lane) * (1.f / D); s2 = 0.f;
#pragma unroll
        for (int j = 0; j < 4; ++j) { v[j] = v[j] - mean; s2 += (v[j].x * v[j].x + v[j].y * v[j].y) + (v[j].z * v[j].z + v[j].w * v[j].w); }
        rstd = 1.f / sqrtf(wave_sum(s2, lane) * (1.f / D) + LN_EPS);
        GAS unsigned long long* o8 = (GAS unsigned long long*)(HB + (size_t)row * D) + lane;
#pragma unroll
        for (int j = 0; j < 4; ++j) { const f32x4 sh = *(const f32x4*)(mb + 3072 + 256 * j + 4 * lane), sc = *(const f32x4*)(mb + 4096 + 256 * j + 4 * lane);
            const f32x4 y = v[j] * rstd * (sc + 1.0f) + sh;
            o8[64 * j] = (unsigned long long)pk2(y.x, y.y) | ((unsigned long long)pk2(y.z, y.w) << 32); }
    }
    }
    xcd_barrier(xbar);

    {
        PHASE_IDS;
        pg8::Gemm g{HB, Wt_f1, MROWS, 2 * DFF, D, D, D, 0}; pg8::StaticOrder S; S.init(MROWS, 2 * DFF, G, gc);
        pg8::EpiSwiglu E{ACT};
        pg8::gemm_phase<pg8::EpiSwiglu, pg8::StaticOrder, true, true>((LAS unsigned char*)lds, g, S, E);
    }
    xcd_barrier(xbar);

    {
        PHASE_IDS;
        pg8::Gemm g{ACT, Wt_f2, MROWS, D, DFF, DFF, DFF, 0}; pg8::StaticOrder S; S.init(MROWS, D, G, gc);
        pg8::EpiGate E{Y2, MOD + 5120};
        pg8::gemm_phase<pg8::EpiGate, pg8::StaticOrder, true, true>((LAS unsigned char*)lds, g, S, E);
    }
    xcd_barrier(xbar);

    {
        PHASE_IDS;
        f32x4 g2v[4], b2v[4];
#pragma unroll
        for (int jj = 0; jj < 4; ++jj) { g2v[jj] = *(const f32x4*)(ln2_g + 256 * jj + 4 * lane); b2v[jj] = *(const f32x4*)(ln2_b + 256 * jj + 4 * lane); }
    for (int row = gw; row < MROWS; row += NGW) {
        GAS f32x4* zr = (GAS f32x4*)(out + (size_t)row * D) + lane;
        const GAS unsigned long long* yr = (const GAS unsigned long long*)(Y2 + (size_t)row * D) + lane;
        f32x4 v[4]; float s = 0.f;
#pragma unroll
        for (int j = 0; j < 4; ++j) { const f32x4 xv = __builtin_nontemporal_load(&zr[64 * j]); const unsigned long long yy = __builtin_nontemporal_load(&yr[64 * j]); const unsigned ylo = (unsigned)yy, yhi = (unsigned)(yy >> 32);
            v[j] = xv * ALPHA + (f32x4){pg8::bf_lo(ylo), pg8::bf_hi(ylo), pg8::bf_lo(yhi), pg8::bf_hi(yhi)};
            s += (v[j].x + v[j].y) + (v[j].z + v[j].w); }
        const float mean = wave_sum(s, lane) * (1.f / D); float s2 = 0.f;
#pragma unroll
        for (int j = 0; j < 4; ++j) { v[j] = v[j] - mean; s2 += (v[j].x * v[j].x + v[j].y * v[j].y) + (v[j].z * v[j].z + v[j].w * v[j].w); }
        const float rstd = 1.f / sqrtf(wave_sum(s2, lane) * (1.f / D) + LN_EPS);
#pragma unroll
        for (int j = 0; j < 4; ++j) { const f32x4 gg = g2v[j], bb = b2v[j];
            __builtin_nontemporal_store(v[j] * rstd * gg + bb, &zr[64 * j]); }
    }
    }
}

extern "C" void kernel_launch(void* const* d_in, const int* in_sizes, int n_in, void* d_out, int out_size, void* d_ws, size_t ws_size, hipStream_t stream) {
    static int grid = 0;
    if (grid == 0) {
        if (n_in != 19 || in_sizes[0] != MROWS * D || out_size != MROWS * D || ws_size < WS_END) {
            fprintf(stderr, "kernel_launch: shape mismatch: n_in %d in0 %d out %d ws %zu (need >= %zu)\n", n_in, n_in > 0 ? in_sizes[0] : -1, out_size, ws_size, (size_t)WS_END); grid = -1; return; }
        int dev = 0, cus = 0, per_cu = 0;
        if (hipGetDevice(&dev) != hipSuccess || hipDeviceGetAttribute(&cus, hipDeviceAttributeMultiprocessorCount, dev) != hipSuccess) { grid = -1; return; }
        if (hipFuncSetAttribute((const void*)mega_fwd, hipFuncAttributeMaxDynamicSharedMemorySize, LDS_BYTES) != hipSuccess) { fprintf(stderr, "kernel_launch: hipFuncSetAttribute failed\n"); grid = -1; return; }
        if (hipOccupancyMaxActiveBlocksPerMultiprocessor(&per_cu, (const void*)mega_fwd, NWAVES * 64, LDS_BYTES) != hipSuccess || per_cu < 1) { fprintf(stderr, "kernel_launch: occupancy query gave %d\n", per_cu); per_cu = 1; }
        (void)hipGetLastError();
        grid = cus * per_cu; if (grid > 256) grid = 256;
    }
    if (grid < 0) return;
    if (hipMemsetAsync(d_ws, 0, 32768, stream) != hipSuccess) { fprintf(stderr, "kernel_launch: memset failed\n"); return; }
    Args a{};
    for (int i = 0; i < 19; ++i) a.in[i] = (const float*)d_in[i];
    a.out = (float*)d_out; a.ws = (unsigned char*)d_ws;
    void* kargs[] = {&a};
    const hipError_t e = hipLaunchCooperativeKernel((const void*)mega_fwd, dim3(grid), dim3(NWAVES * 64), kargs, LDS_BYTES, stream);
    if (e != hipSuccess) fprintf(stderr, "kernel_launch: cooperative launch failed: %s (grid %d)\n", hipGetErrorString(e), grid);
}
```

```cpp
#include <hip/hip_runtime.h>
#include <hip/hip_cooperative_groups.h>
#include <cstdio>
#include <cstdint>
namespace cg = cooperative_groups;

constexpr int D = 1024, BATCH = 32, SEQ = 2048, MROWS = BATCH * SEQ, NH = 8, INC = 5632, DFF = 2816, PIN = 512, NMOD = 6144;
constexpr float ALPHA = 1.189207115002721f;
constexpr float LN_EPS = 1e-5f, RMS_EPS = 1e-5f;
constexpr float LOG2E = 1.4426950408889634f;
constexpr float QSCALE = 0.125f * LOG2E;

#ifndef HEADMAJOR
#define HEADMAJOR 1
#endif
namespace pg8 {
#define PG8_LAS __attribute__((address_space(3)))
typedef unsigned short bf16_t;
typedef short bf16x8 __attribute__((ext_vector_type(8)));
typedef float f32x4 __attribute__((ext_vector_type(4)));
typedef unsigned u32x4 __attribute__((ext_vector_type(4)));
constexpr int BM = 256, BK = 64, HALF = 128, HTB = HALF * BK * 2  , STAGE_BYTES = 8 * HTB, NXCD = 8, WGM = 8;

__host__ __device__ __forceinline__ int lds_byte(int r, int c) { const int st = (r >> 4) * 2 + (c >> 5), rr = r & 15, cc = c & 31, ob = rr * 64 + cc * 2; return st * 1024 + (ob ^ (((ob >> 9) & 1) << 5)); }
__host__ __device__ __forceinline__ void stage_rc(int b, int& R, int& C) { const int st = b / 1024, sb = b % 1024, swz = sb ^ (((sb >> 9) & 1) << 5); R = (st >> 1) * 16 + swz / 64; C = (st & 1) * 32 + (swz % 64) / 2; }
__host__ __device__ __forceinline__ int perm32(int rho) { const int n = rho >> 4, i = rho & 15; return 8 * (i >> 2) + 4 * n + (i & 3); }

struct Unit { int pm, pn; };
struct Gemm { const bf16_t* A; const bf16_t* Bt; int M, N, K, lda, ldb, apn; };

struct StaticOrder {
    int nM, nN, nwg, G, c;
    __host__ __device__ void init(int M, int N, int G_, int c_) { nM = M / BM; nN = N / BM; nwg = nM * nN; G = G_; c = c_; }
    __host__ __device__ bool next(int i, Unit& u) const {
        const long L = (long)i * G + c; if (L >= nwg) return false;
        int wgid = (int)L; { const int q = nwg / NXCD, r = nwg % NXCD, xcd = wgid % NXCD, off = wgid / NXCD; wgid = (xcd < r ? xcd * (q + 1) : r * (q + 1) + (xcd - r) * q) + off; }
        const int nig = WGM * nN, gid = wgid / nig, fm = gid * WGM, gsz = (nM - fm) < WGM ? (nM - fm) : WGM;
        u.pm = fm + ((wgid % nig) % gsz); u.pn = (wgid % nig) / gsz; return true;
    }
    __device__ __forceinline__ void a_ready(const Unit&) const {}
    __device__ __forceinline__ void done(const Unit&) const {}
};


__device__ __forceinline__ unsigned cvt_pk_bf16(float lo, float hi) { unsigned r; asm volatile("v_cvt_pk_bf16_f32 %0, %1, %2" : "=v"(r) : "v"(lo), "v"(hi)); return r; }
__device__ __forceinline__ float bf_lo(unsigned w) { return __uint_as_float(w << 16); }
__device__ __forceinline__ float bf_hi(unsigned w) { return __uint_as_float(w & 0xffff0000u); }
__device__ __forceinline__ float sigm(float x) { return __builtin_amdgcn_rcpf(1.0f + __builtin_amdgcn_exp2f(-1.4426950408889634f * x)); }

struct EpiProj {
    static constexpr bool PERM = true, AFTER_DRAIN = false;
    bf16_t *Q, *Kb, *V, *U, *G; float qscale; unsigned* nrmk;
    __device__ __forceinline__ void operator()(const f32x4 (&acc)[2][2][4][2], const Unit& u, int wr, int wc, int fr, int fq) const {
        const int pn = u.pn;
        if (pn >= 4 && pn < 8) {
            const int lane = fq * 16 + fr;
#pragma unroll
            for (int bj = 0; bj < 2; ++bj) { float mx = 0.f;
#pragma unroll
                for (int ai = 0; ai < 2; ++ai)
#pragma unroll
                    for (int m = 0; m < 4; ++m) { const f32x4 a = acc[ai][bj][m][0], c = acc[ai][bj][m][1];
                        float s = (a[0] * a[0] + a[1] * a[1]) + (a[2] * a[2] + a[3] * a[3]) + (c[0] * c[0] + c[1] * c[1]) + (c[2] * c[2] + c[3] * c[3]);
                        s += __builtin_bit_cast(float, __builtin_amdgcn_ds_bpermute((lane ^ 16) << 2, __builtin_bit_cast(int, s)));
                        s += __builtin_bit_cast(float, __builtin_amdgcn_ds_bpermute((lane ^ 32) << 2, __builtin_bit_cast(int, s)));
                        mx = fmaxf(mx, s); }
#pragma unroll
                for (int x = 1; x < 16; x <<= 1) mx = fmaxf(mx, __builtin_bit_cast(float, __builtin_amdgcn_ds_bpermute((lane ^ x) << 2, __builtin_bit_cast(int, mx))));
                if (lane == 0) atomicMax(nrmk + (((u.pm >> 3) * 8 + 2 * (pn - 4) + bj) * 2 + (wc >> 1)) * 2 + (wc & 1), __float_as_uint(mx)); }
        }
        if (HEADMAJOR && pn < 12) {
            bf16_t* base; int ct; float sc = 1.f;
            if (pn < 4) { base = Q; ct = pn; sc = qscale; } else if (pn < 8) { base = Kb; ct = pn - 4; } else { base = V; ct = pn - 8; }
            const int b = u.pm >> 3, t0 = (u.pm & 7) * BM + wr * 64 + fr;
#pragma unroll
            for (int bj = 0; bj < 2; ++bj) { bf16_t* hb = base + ((size_t)((b * 8 + 2 * ct + bj) * 2048 + t0)) * 128 + wc * 32 + 8 * fq;
#pragma unroll
                for (int ai = 0; ai < 2; ++ai)
#pragma unroll
                    for (int m = 0; m < 4; ++m) { const f32x4 v0 = acc[ai][bj][m][0] * sc, v1 = acc[ai][bj][m][1] * sc;
                        u32x4 w; w.x = cvt_pk_bf16(v0[0], v0[1]); w.y = cvt_pk_bf16(v0[2], v0[3]); w.z = cvt_pk_bf16(v1[0], v1[1]); w.w = cvt_pk_bf16(v1[2], v1[3]);
                        __builtin_nontemporal_store(w, (u32x4*)(hb + (ai * HALF + m * 16) * 128)); } }
        } else {
            bf16_t* base; int ld, ct; float sc = 1.f;
            if (pn < 4) { base = Q; ld = 1024; ct = pn; sc = qscale; } else if (pn < 8) { base = Kb; ld = 1024; ct = pn - 4; } else if (pn < 12) { base = V; ld = 1024; ct = pn - 8; }
            else if (pn < 14) { base = U; ld = 512; ct = pn - 12; } else { base = G; ld = 2048; ct = pn - 14; }
            const int row0 = u.pm * BM + wr * 64 + fr, col0 = ct * 256 + wc * 32 + 8 * fq;
#pragma unroll
            for (int ai = 0; ai < 2; ++ai)
#pragma unroll
                for (int m = 0; m < 4; ++m) { bf16_t* rowp = base + (size_t)(row0 + ai * HALF + m * 16) * ld + col0;
#pragma unroll
                    for (int bj = 0; bj < 2; ++bj) { const f32x4 v0 = acc[ai][bj][m][0] * sc, v1 = acc[ai][bj][m][1] * sc;
                        u32x4 w; w.x = cvt_pk_bf16(v0[0], v0[1]); w.y = cvt_pk_bf16(v0[2], v0[3]); w.z = cvt_pk_bf16(v1[0], v1[1]); w.w = cvt_pk_bf16(v1[2], v1[3]);
                        __builtin_nontemporal_store(w, (u32x4*)(rowp + bj * HALF)); } }
        }
    }
};
struct EpiGate {
    static constexpr bool PERM = true, AFTER_DRAIN = false;
    bf16_t* out; const float* gate;
    __device__ __forceinline__ void operator()(const f32x4 (&acc)[2][2][4][2], const Unit& u, int wr, int wc, int fr, int fq) const {
        const int row0 = u.pm * BM + wr * 64 + fr, col0 = u.pn * 256 + wc * 32 + 8 * fq;
        const float* gp = gate + (size_t)(u.pm >> 3) * 6144 + col0;
        f32x4 gq[2][2];
#pragma unroll
        for (int bj = 0; bj < 2; ++bj) { gq[bj][0] = *(const f32x4*)(gp + bj * HALF); gq[bj][1] = *(const f32x4*)(gp + bj * HALF + 4); }
#pragma unroll
        for (int bj = 0; bj < 2; ++bj) { const f32x4 g0 = gq[bj][0], g1 = gq[bj][1];
#pragma unroll
            for (int ai = 0; ai < 2; ++ai)
#pragma unroll
                for (int m = 0; m < 4; ++m) { const f32x4 v0 = acc[ai][bj][m][0] * g0, v1 = acc[ai][bj][m][1] * g1;
                    u32x4 w; w.x = cvt_pk_bf16(v0[0], v0[1]); w.y = cvt_pk_bf16(v0[2], v0[3]); w.z = cvt_pk_bf16(v1[0], v1[1]); w.w = cvt_pk_bf16(v1[2], v1[3]);
                    *(u32x4*)(out + (size_t)(row0 + ai * HALF + m * 16) * 1024 + col0 + bj * HALF) = w; } }
    }
};
struct EpiSwiglu {
    static constexpr bool PERM = true, AFTER_DRAIN = false;
    bf16_t* out;
    __device__ __forceinline__ void operator()(const f32x4 (&acc)[2][2][4][2], const Unit& u, int wr, int wc, int fr, int fq) const {
        const int row0 = u.pm * BM + wr * 64 + fr, col0 = u.pn * 128 + wc * 32 + 8 * fq;
#pragma unroll
        for (int ai = 0; ai < 2; ++ai)
#pragma unroll
            for (int m = 0; m < 4; ++m) { bf16_t* rowp = out + (size_t)(row0 + ai * HALF + m * 16) * 2816 + col0;
                const f32x4 g0 = acc[ai][0][m][0], g1 = acc[ai][0][m][1], u0 = acc[ai][1][m][0], u1 = acc[ai][1][m][1];
                u32x4 w;
                w.x = cvt_pk_bf16(g0[0] * sigm(g0[0]) * u0[0], g0[1] * sigm(g0[1]) * u0[1]);
                w.y = cvt_pk_bf16(g0[2] * sigm(g0[2]) * u0[2], g0[3] * sigm(g0[3]) * u0[3]);
                w.z = cvt_pk_bf16(g1[0] * sigm(g1[0]) * u1[0], g1[1] * sigm(g1[1]) * u1[1]);
                w.w = cvt_pk_bf16(g1[2] * sigm(g1[2]) * u1[2], g1[3] * sigm(g1[3]) * u1[3]);
                __builtin_nontemporal_store(w, (u32x4*)rowp); }
    }
};

template <class Epi, class Sched, bool ALIGN_EPI = false, bool SP2 = false>
__device__ __forceinline__ void gemm_phase(PG8_LAS unsigned char* lds, const Gemm g, const Sched& S, const Epi& E) {
    int tid_ = threadIdx.x; asm volatile("" : "+v"(tid_));
    const int tid = tid_, wid = __builtin_amdgcn_readfirstlane(tid >> 6), lane = tid & 63, wr = wid >> 2, wc = wid & 3, fr = lane & 15, fq = lane >> 4;
    const int K = g.K, nt = K / BK;
    unsigned voffA[2], voffB[2];
#pragma unroll
    for (int i = 0; i < 2; ++i) { int R, C; stage_rc(tid * 16 + i * 8192, R, C); const int Rb = Epi::PERM ? ((R & ~31) + perm32(R & 31)) : R;
        voffA[i] = (unsigned)(R * g.lda + C) * 2u; voffB[i] = (unsigned)(Rb * g.ldb + C) * 2u; }
    const size_t kstep = (size_t)(BK * 2);
    const size_t hstepA = (size_t)HALF * g.lda * 2, hstepB = (size_t)HALF * g.ldb * 2;
    const size_t tstepA = 2 * hstepA, tstepB = 2 * hstepB, apn = (size_t)g.apn;
    const unsigned ldsw = (unsigned)wid * 1024u;
    const int aoff = lds_byte(wr * 64 + fr, fq * 8), boff = lds_byte(wc * 32 + fr, fq * 8);
#define PG8_SA(b, h) (((b) * 2 + (h)) * HTB)
#define PG8_SB(b, h) ((4 + (b) * 2 + (h)) * HTB)
#define PG8_STAGE(bufoff, gbase, voff) do { _Pragma("unroll") for (int _i = 0; _i < 2; ++_i) \
        __builtin_amdgcn_global_load_lds((const unsigned*)((const char*)(gbase) + (voff)[_i]), (PG8_LAS unsigned*)(lds + (bufoff) + ldsw + _i * 8192), 16, 0, 0); } while (0)
#define PG8_LDA(dst, b, h) do { _Pragma("unroll") for (int m = 0; m < 4; ++m) _Pragma("unroll") for (int k = 0; k < 2; ++k) dst[m][k] = *(const PG8_LAS bf16x8*)(lds + PG8_SA(b, h) + aoff + m * 2048 + k * 1024); } while (0)
#define PG8_LDB(dst, b, h) do { _Pragma("unroll") for (int n = 0; n < 2; ++n) _Pragma("unroll") for (int k = 0; k < 2; ++k) dst[n][k] = *(const PG8_LAS bf16x8*)(lds + PG8_SB(b, h) + boff + n * 2048 + k * 1024); } while (0)
#define PG8_MMA(ai, bj, At, Bt) do { __builtin_amdgcn_s_setprio(1); _Pragma("unroll") for (int m = 0; m < 4; ++m) _Pragma("unroll") for (int n = 0; n < 2; ++n) _Pragma("unroll") for (int k = 0; k < 2; ++k) \
        acc[ai][bj][m][n] = __builtin_amdgcn_mfma_f32_16x16x32_bf16(Bt[n][k], At[m][k], acc[ai][bj][m][n], 0, 0, 0); __builtin_amdgcn_s_setprio(0); } while (0)
#define PG8_WAIT_V(n) asm volatile("s_waitcnt vmcnt(" #n ")" ::: "memory")
#define PG8_WAIT_L(n) asm volatile("s_waitcnt lgkmcnt(" #n ")" ::: "memory")
#define PG8_BAR __builtin_amdgcn_s_barrier()
#define PG8_SCHED __builtin_amdgcn_sched_barrier(0)
    Unit cur, nxt; int ui = 0;
    if (!S.next(0, cur)) return;
    f32x4 acc[2][2][4][2];
#pragma unroll
    for (int a = 0; a < 2; ++a)
#pragma unroll
        for (int b = 0; b < 2; ++b)
#pragma unroll
            for (int m = 0; m < 4; ++m)
#pragma unroll
                for (int n = 0; n < 2; ++n) acc[a][b][m][n] = (f32x4){0.f, 0.f, 0.f, 0.f};
    bf16x8 At[4][2], B0[2][2], B1[2][2];
    const char* cA = (const char*)g.A + (size_t)cur.pm * tstepA + (size_t)cur.pn * apn; const char* cB = (const char*)g.Bt + (size_t)cur.pn * tstepB;
    S.a_ready(cur);
    if constexpr (SP2) {
        PG8_STAGE(PG8_SB(0, 0), cB, voffB); PG8_STAGE(PG8_SB(0, 1), cB + hstepB, voffB); PG8_STAGE(PG8_SA(0, 0), cA, voffA); PG8_STAGE(PG8_SA(0, 1), cA + hstepA, voffA);
        if (wr == 1) PG8_BAR;
        PG8_WAIT_V(2); PG8_BAR;
        PG8_STAGE(PG8_SB(1, 0), cB + kstep, voffB); PG8_STAGE(PG8_SA(1, 0), cA + kstep, voffA); PG8_STAGE(PG8_SB(1, 1), cB + hstepB + kstep, voffB);
        PG8_WAIT_V(6); PG8_BAR;
    } else {
        PG8_STAGE(PG8_SB(0, 0), cB, voffB); PG8_STAGE(PG8_SA(0, 0), cA, voffA); PG8_STAGE(PG8_SB(0, 1), cB + hstepB, voffB); PG8_STAGE(PG8_SA(0, 1), cA + hstepA, voffA);
        if (wr == 1) PG8_BAR;
        PG8_WAIT_V(4); PG8_BAR;
        PG8_STAGE(PG8_SB(1, 0), cB + kstep, voffB); PG8_STAGE(PG8_SA(1, 0), cA + kstep, voffA); PG8_STAGE(PG8_SB(1, 1), cB + hstepB + kstep, voffB);
        PG8_WAIT_V(6); PG8_BAR;
    }
    for (;;) {
        const bool has_next = S.next(ui + 1, nxt);
        const char* nA = has_next ? (const char*)g.A + (size_t)nxt.pm * tstepA + (size_t)nxt.pn * apn : cA; const char* nB = has_next ? (const char*)g.Bt + (size_t)nxt.pn * tstepB : cB;
        for (int t = 0; t < nt; t += 2) {
            const bool last = (t == nt - 2);
            const char* a1 = cA + (size_t)(t + 1) * kstep;
            const char* a2 = last ? nA : cA + (size_t)(t + 2) * kstep; const char* b2 = last ? nB : cB + (size_t)(t + 2) * kstep;
            const char* a3 = a2 + kstep; const char* b3 = b2 + kstep;
            if (last && has_next) S.a_ready(nxt);
            if constexpr (SP2) {
            PG8_LDB(B0, 0, 0); PG8_LDB(B1, 0, 1); PG8_SCHED; PG8_LDA(At, 0, 0); PG8_STAGE(PG8_SA(1, 1), a1 + hstepA, voffA);
            PG8_WAIT_V(8); PG8_WAIT_L(0); PG8_BAR; PG8_MMA(0, 0, At, B0); PG8_MMA(0, 1, At, B1); PG8_BAR; PG8_SCHED;
            PG8_LDA(At, 0, 1); PG8_STAGE(PG8_SB(0, 0), b2, voffB); PG8_STAGE(PG8_SB(0, 1), b2 + hstepB, voffB); PG8_STAGE(PG8_SA(0, 0), a2, voffA);
            PG8_WAIT_V(8); PG8_WAIT_L(0); PG8_BAR; PG8_MMA(1, 0, At, B0); PG8_MMA(1, 1, At, B1); PG8_BAR; PG8_SCHED;
            PG8_LDB(B0, 1, 0); PG8_LDB(B1, 1, 1); PG8_SCHED; PG8_LDA(At, 1, 0); PG8_STAGE(PG8_SA(0, 1), a2 + hstepA, voffA);
            PG8_WAIT_V(8); PG8_WAIT_L(0); PG8_BAR; PG8_MMA(0, 0, At, B0); PG8_MMA(0, 1, At, B1); PG8_BAR; PG8_SCHED;
            PG8_LDA(At, 1, 1); PG8_STAGE(PG8_SB(1, 0), b3, voffB); PG8_STAGE(PG8_SB(1, 1), b3 + hstepB, voffB); PG8_STAGE(PG8_SA(1, 0), a3, voffA);
            PG8_WAIT_V(8); PG8_WAIT_L(0); PG8_BAR; PG8_MMA(1, 0, At, B0); PG8_MMA(1, 1, At, B1); PG8_BAR; PG8_SCHED;
            } else {
            PG8_LDB(B0, 0, 0); PG8_SCHED; PG8_LDA(At, 0, 0); PG8_STAGE(PG8_SA(1, 1), a1 + hstepA, voffA);
            PG8_WAIT_L(8); PG8_BAR; PG8_WAIT_L(0); PG8_MMA(0, 0, At, B0); PG8_BAR; PG8_SCHED;
            PG8_LDB(B1, 0, 1); PG8_STAGE(PG8_SB(0, 0), b2, voffB);
            PG8_BAR; PG8_WAIT_L(0); PG8_MMA(0, 1, At, B1); PG8_BAR;
            PG8_LDA(At, 0, 1); PG8_STAGE(PG8_SA(0, 0), a2, voffA);
            PG8_BAR; PG8_WAIT_L(0); PG8_MMA(1, 0, At, B0); PG8_BAR; PG8_SCHED;
            PG8_STAGE(PG8_SB(0, 1), b2 + hstepB, voffB);
            PG8_WAIT_V(6); PG8_BAR; PG8_MMA(1, 1, At, B1); PG8_BAR;
            PG8_LDB(B0, 1, 0); PG8_SCHED; PG8_LDA(At, 1, 0); PG8_STAGE(PG8_SA(0, 1), a2 + hstepA, voffA);
            PG8_WAIT_L(8); PG8_BAR; PG8_WAIT_L(0); PG8_MMA(0, 0, At, B0); PG8_BAR; PG8_SCHED;
            PG8_LDB(B1, 1, 1); PG8_STAGE(PG8_SB(1, 0), b3, voffB);
            PG8_BAR; PG8_WAIT_L(0); PG8_MMA(0, 1, At, B1); PG8_BAR;
            PG8_LDA(At, 1, 1); PG8_STAGE(PG8_SA(1, 0), a3, voffA);
            PG8_BAR; PG8_WAIT_L(0); PG8_MMA(1, 0, At, B0); PG8_BAR; PG8_SCHED;
            PG8_STAGE(PG8_SB(1, 1), b3 + hstepB, voffB);
            PG8_WAIT_V(6); PG8_BAR; PG8_MMA(1, 1, At, B1); PG8_BAR;
            }
        }
        if constexpr (ALIGN_EPI) { if (wr == 0) PG8_BAR; }
        if constexpr (!Epi::AFTER_DRAIN) { E(acc, cur, wr, wc, fr, fq); S.done(cur); }
        if (!has_next) break;
#pragma unroll
        for (int a = 0; a < 2; ++a)
#pragma unroll
            for (int b = 0; b < 2; ++b)
#pragma unroll
                for (int m = 0; m < 4; ++m)
#pragma unroll
                    for (int n = 0; n < 2; ++n) acc[a][b][m][n] = (f32x4){0.f, 0.f, 0.f, 0.f};
        cur = nxt; cA = nA; cB = nB; ++ui;
        if constexpr (ALIGN_EPI) { if (wr == 1) PG8_BAR; }
    }
    PG8_WAIT_V(0);
    if constexpr (!ALIGN_EPI) { if (wr == 0) PG8_BAR; }
    PG8_BAR;
    if constexpr (Epi::AFTER_DRAIN) { E.fused(acc, cur, wr, wc, fr, fq, lds, wid, lane); S.done(cur); }
#undef PG8_SA
#undef PG8_SB
#undef PG8_STAGE
#undef PG8_LDA
#undef PG8_LDB
#undef PG8_MMA
#undef PG8_WAIT_V
#undef PG8_WAIT_L
#undef PG8_BAR
#undef PG8_SCHED
}
}

namespace attn {
typedef unsigned short bf16_t;
using bf16x8 = __attribute__((ext_vector_type(8))) short;
using s16x4  = __attribute__((ext_vector_type(4))) short;
using f32x16 = __attribute__((ext_vector_type(16))) float;
using u32x4  = __attribute__((ext_vector_type(4))) unsigned;
constexpr int NW = 8, QBLK = 32, KVBLK = 64, LD = HEADMAJOR ? 128 : 1024;
constexpr size_t SHM_V = KVBLK * 128 * 2, SHM_K = KVBLK * 128 * 2, SHM_ATTN = 2 * SHM_V + 2 * SHM_K + NW * 64 * 4;
#ifndef ATT_REP
#define ATT_REP 1
#endif
constexpr float TSKIP = 40.f;
constexpr float THRL = 11.5f;
#define KSWZ(row, colB) ((row) * 256 + ((colB) ^ (((row) & 7) << 4)))
#define SBAR() __builtin_amdgcn_sched_barrier(0)
__device__ __forceinline__ int crow(int r, int hi) { return (r & 3) + 8 * (r >> 2) + 4 * hi; }
__device__ __forceinline__ unsigned cvtpk(float lo, float hi) { unsigned r; asm volatile("v_cvt_pk_bf16_f32 %0, %1, %2" : "=v"(r) : "v"(lo), "v"(hi)); return r; }
__device__ __forceinline__ bf16x8 ld8(const bf16_t* p) { return *reinterpret_cast<const bf16x8*>(p); }

__device__ __forceinline__ int v_st(int k, int c) { const int kk = (k & ~0xC) | ((k & 4) << 1) | ((k & 8) >> 1); return ((kk >> 3) * 4 + (c >> 5)) * 512 + ((kk & 7) * 32 + (c & 31)) * 2; }
__device__ __forceinline__ int v_rd_base(int lane) { return ((lane & 3) << 3) | (((lane >> 2) & 3) << 6) | (((lane >> 4) & 1) << 5) | (((lane >> 5) & 1) << 8); }
constexpr int v_rd_off(int d0, int ks, int half) { return d0 * 512 + ks * 4096 + half * 2048; }
template <int OFF> __device__ __forceinline__ s16x4 tr_read(int vb) {
  s16x4 r; asm volatile("ds_read_b64_tr_b16 %0, %1 offset:%2" : "=&v"(r) : "v"(vb), "i"(OFF) : "memory"); return r;
}
template <int D0> __device__ __forceinline__ void pv_one(f32x16& od, int vb, bf16x8 pa0, bf16x8 pa1, bf16x8 pa2, bf16x8 pa3) {
  const s16x4 l0 = tr_read<v_rd_off(D0, 0, 0)>(vb), h0 = tr_read<v_rd_off(D0, 0, 1)>(vb), l1 = tr_read<v_rd_off(D0, 1, 0)>(vb), h1 = tr_read<v_rd_off(D0, 1, 1)>(vb);
  const s16x4 l2 = tr_read<v_rd_off(D0, 2, 0)>(vb), h2 = tr_read<v_rd_off(D0, 2, 1)>(vb), l3 = tr_read<v_rd_off(D0, 3, 0)>(vb), h3 = tr_read<v_rd_off(D0, 3, 1)>(vb);
  asm volatile("s_waitcnt lgkmcnt(0)" ::: "memory"); SBAR();
#define PK(L, H) (bf16x8){L[0], L[1], L[2], L[3], H[0], H[1], H[2], H[3]}
  od = __builtin_amdgcn_mfma_f32_32x32x16_bf16(pa0, PK(l0, h0), od, 0, 0, 0);
  od = __builtin_amdgcn_mfma_f32_32x32x16_bf16(pa1, PK(l1, h1), od, 0, 0, 0);
  od = __builtin_amdgcn_mfma_f32_32x32x16_bf16(pa2, PK(l2, h2), od, 0, 0, 0);
  od = __builtin_amdgcn_mfma_f32_32x32x16_bf16(pa3, PK(l3, h3), od, 0, 0, 0);
#undef PK
}
__device__ __forceinline__ void pv_d0(f32x16* o, int vb, bf16x8 pa0, bf16x8 pa1, bf16x8 pa2, bf16x8 pa3) {
  pv_one<0>(o[0], vb, pa0, pa1, pa2, pa3); pv_one<1>(o[1], vb, pa0, pa1, pa2, pa3); pv_one<2>(o[2], vb, pa0, pa1, pa2, pa3); pv_one<3>(o[3], vb, pa0, pa1, pa2, pa3);
}

constexpr size_t SHM_X = 2 * SHM_V + 2 * SHM_K + NW * 64 * 4;
constexpr size_t SHM_ATTN_PP = SHM_X + 4 * 64 * 64 * 4;
__device__ __forceinline__ void qkt_c(f32x16& p0, f32x16& p1, const char* Ks, const bf16x8* qr, const f32x16& negm, int r32, int hi) {
#pragma unroll
  for (int d0 = 0; d0 < 4; ++d0) { const int cb = (d0 * 16 + hi * 8) * 2;
    bf16x8 b0 = *reinterpret_cast<const bf16x8*>(Ks + KSWZ(r32, cb));
    bf16x8 b1 = *reinterpret_cast<const bf16x8*>(Ks + KSWZ(32 + r32, cb));
    if (d0 == 0) { p0 = __builtin_amdgcn_mfma_f32_32x32x16_bf16(b0, qr[0], negm, 0, 0, 0); p1 = __builtin_amdgcn_mfma_f32_32x32x16_bf16(b1, qr[0], negm, 0, 0, 0); }
    else { p0 = __builtin_amdgcn_mfma_f32_32x32x16_bf16(b0, qr[d0], p0, 0, 0, 0); p1 = __builtin_amdgcn_mfma_f32_32x32x16_bf16(b1, qr[d0], p1, 0, 0, 0); } }
}
template <int R> __device__ __forceinline__ void bias_r(f32x16& p0, f32x16& p1, float dq, float nslope) {
  constexpr int C0 = (R & 3) + 8 * (R >> 2);
  float x0, x1, a0 = p0[R], a1 = p1[R];
  asm("v_sub_f32_e32 %0, %1, %2" : "=v"(x0) : "n"(__builtin_bit_cast(int, (float)C0)), "v"(dq));
  asm("v_sub_f32_e32 %0, %1, %2" : "=v"(x1) : "n"(__builtin_bit_cast(int, (float)(C0 + 32))), "v"(dq));
  asm("v_fma_f32 %0, %1, |%2|, %0" : "+v"(a0) : "v"(nslope), "v"(x0));
  asm("v_fma_f32 %0, %1, |%2|, %0" : "+v"(a1) : "v"(nslope), "v"(x1));
  p0[R] = a0; p1[R] = a1;
  if constexpr (R < 15) bias_r<R + 1>(p0, p1, dq, nslope);
}
__device__ __forceinline__ bool softmax_pp(f32x16& p0, f32x16& p1, float& m_reg, float& l_reg, f32x16& negm, float& alpha, float& m_run, float dq, float nslope,
                                           bf16x8& pa0, bf16x8& pa1, bf16x8& pa2, bf16x8& pa3) {
  bias_r<0>(p0, p1, dq, nslope);
  float a = fmaxf(fmaxf(p0[0], p0[1]), p1[0]), bq = fmaxf(fmaxf(p0[2], p0[3]), p1[1]); a = fmaxf(fmaxf(a, p1[2]), p1[3]);
#pragma unroll
  for (int r = 4; r < 16; r += 4) { a = fmaxf(fmaxf(a, p0[r]), p0[r + 1]); bq = fmaxf(fmaxf(bq, p0[r + 2]), p0[r + 3]); a = fmaxf(fmaxf(a, p1[r]), p1[r + 1]); bq = fmaxf(fmaxf(bq, p1[r + 2]), p1[r + 3]); }
  float pmax = fmaxf(a, bq);
  { auto rr = __builtin_amdgcn_permlane32_swap(__float_as_uint(pmax), __float_as_uint(pmax), false, false);
    pmax = fmaxf(__uint_as_float(rr[0]), __uint_as_float(rr[1])); }
  alpha = 1.f;
  { const float tmax = pmax + m_reg;
    if (__all(tmax < m_run - TSKIP)) return false;
    m_run = fmaxf(m_run, tmax); }
  if (__builtin_expect(!__all(pmax <= THRL), 0)) { const float dl = fmaxf(pmax, 0.f); m_reg += dl; alpha = __builtin_amdgcn_exp2f(-dl);
#pragma unroll
    for (int r = 0; r < 16; ++r) { p0[r] -= dl; p1[r] -= dl; }
#pragma unroll
    for (int r = 0; r < 16; ++r) negm[r] = -m_reg; }
#pragma unroll
  for (int r = 0; r < 16; ++r) { p0[r] = __builtin_amdgcn_exp2f(p0[r]); p1[r] = __builtin_amdgcn_exp2f(p1[r]); }
  float ps = 0;
#pragma unroll
  for (int r = 0; r < 16; ++r) ps += p0[r];
#pragma unroll
  for (int r = 0; r < 16; ++r) ps += p1[r];
  { auto rr = __builtin_amdgcn_permlane32_swap(__float_as_uint(ps), __float_as_uint(ps), false, false);
    ps = __uint_as_float(rr[0]) + __uint_as_float(rr[1]); }
  l_reg = l_reg * alpha + ps;
#define PK4(P, BASE, OUT) do { unsigned a0 = cvtpk(P[BASE + 0], P[BASE + 1]), a1 = cvtpk(P[BASE + 2], P[BASE + 3]);   \
    unsigned b0 = cvtpk(P[BASE + 4], P[BASE + 5]), b1 = cvtpk(P[BASE + 6], P[BASE + 7]);                              \
    auto r0 = __builtin_amdgcn_permlane32_swap(a0, b0, false, false); auto r1 = __builtin_amdgcn_permlane32_swap(a1, b1, false, false); \
    u32x4 w = {r0[0], r1[0], r0[1], r1[1]}; OUT = *reinterpret_cast<bf16x8*>(&w); } while (0)
  PK4(p0, 0, pa0); PK4(p0, 8, pa1); PK4(p1, 0, pa2); PK4(p1, 8, pa3);
#undef PK4
  return true;
}
__device__ __forceinline__ float sigm_(float x) { return __builtin_amdgcn_rcpf(1.0f + __builtin_amdgcn_exp2f(-1.4426950408889634f * x)); }
__device__ __forceinline__ void attn_unit_pp(int b, int h, int qb, int par, const bf16_t* __restrict__ QBp, const bf16_t* __restrict__ KBp, const bf16_t* __restrict__ VBp,
                                             const bf16_t* __restrict__ GBp, bf16_t* __restrict__ AOp, const bf16_t* __restrict__ PLDp, const bf16_t* __restrict__ WPLp, float lam, const float* __restrict__ sub_g, const unsigned* __restrict__ nrmk, char* lds) {
  int tid_ = threadIdx.x; asm volatile("" : "+v"(tid_));
  const int tid = tid_, wid = tid >> 6, lane = tid & 63, r32 = lane & 31, hi = lane >> 5, w4 = wid & 3, t256 = tid & 255;
  const int g = __builtin_amdgcn_readfirstlane(tid >> 8);
  const long rowbase = (long)b * SEQ; const int q0 = qb * 128;
  const size_t hoff = HEADMAJOR ? (size_t)(b * 8 + h) * SEQ * 128 : (size_t)b * SEQ * 1024 + h * 128;
  const bf16_t* Kh = KBp + hoff; const bf16_t* Vh = VBp + hoff;
  char* V_lds = lds; char* K_lds = lds + 2 * SHM_V;
  float* wsf = (float*)(lds + 2 * SHM_V + 2 * SHM_K) + wid * 64; float* li_l = wsf; float* al_l = wsf + 32;
  const float nslope = -exp2f(-(float)(h + 1)) * 1.4426950408889634f;
  const bf16_t* Qw = QBp + hoff + (size_t)(q0 + w4 * QBLK + r32) * LD + g * 64 + hi * 8;
  bf16x8 qr[4];
#pragma unroll
  for (int d0 = 0; d0 < 4; ++d0) qr[d0] = ld8(Qw + d0 * 16);
  const float qposf = (float)(q0 + w4 * QBLK + r32 - 4 * hi);
  const int sr = t256 >> 4, sc = (t256 & 15) * 8;
  int woff[4];
#pragma unroll
  for (int i = 0; i < 4; ++i) { const int row = sr + 16 * i; woff[i] = g ? (int)(2 * SHM_V) + KSWZ(row, sc * 2) : v_st(row, sc); }
  const bf16_t* Tsrc = (g ? Kh : Vh) + (long)sr * LD + sc;
  const char* Kmine = K_lds + g * 128;
  const int vb0 = (int)(uintptr_t)V_lds + v_rd_base(lane);
  float m_reg = 0.f, l_reg = 0.f, alpha = 1.f; f32x16 o[4]; f32x16 negm = f32x16{}; f32x16 p0, p1; bf16x8 pa0, pa1, pa2, pa3; bf16x8 stg[4];
#pragma unroll
  for (int d = 0; d < 4; ++d) o[d] = f32x16{};
  constexpr int NT = SEQ / KVBLK;
  float qn = 0.f;
#pragma unroll
  for (int d0 = 0; d0 < 4; ++d0) { const u32x4 w = __builtin_bit_cast(u32x4, qr[d0]);
#pragma unroll
    for (int e = 0; e < 4; ++e) { const float lo = __uint_as_float(w[e] << 16), hh = __uint_as_float(w[e] & 0xffff0000u); qn = fmaf(lo, lo, qn); qn = fmaf(hh, hh, qn); } }
  { auto rr = __builtin_amdgcn_permlane32_swap(__float_as_uint(qn), __float_as_uint(qn), false, false); qn = __uint_as_float(rr[0]) + __uint_as_float(rr[1]); }
  float sii = 0.f;
  { const bf16_t* Kw = Kh + (size_t)(q0 + w4 * QBLK + r32) * LD + g * 64 + hi * 8;
#pragma unroll
    for (int d0 = 0; d0 < 4; ++d0) { const u32x4 wq = __builtin_bit_cast(u32x4, qr[d0]); const u32x4 wk = __builtin_bit_cast(u32x4, ld8(Kw + d0 * 16));
#pragma unroll
      for (int e = 0; e < 4; ++e) { sii = fmaf(__uint_as_float(wq[e] << 16), __uint_as_float(wk[e] << 16), sii); sii = fmaf(__uint_as_float(wq[e] & 0xffff0000u), __uint_as_float(wk[e] & 0xffff0000u), sii); } } }
  { auto rr = __builtin_amdgcn_permlane32_swap(__float_as_uint(sii), __float_as_uint(sii), false, false); sii = __uint_as_float(rr[0]) + __uint_as_float(rr[1]); }
  { const unsigned* nk = nrmk + ((size_t)((b * 8 + h) * 2 + g)) * 2; const float kn = __uint_as_float(__hip_atomic_load(nk, __ATOMIC_RELAXED, __HIP_MEMORY_SCOPE_AGENT)) + __uint_as_float(__hip_atomic_load(nk + 1, __ATOMIC_RELAXED, __HIP_MEMORY_SCOPE_AGENT));
    qn = sqrtf(qn * kn) * 1.02f - sii; }
#pragma unroll
  for (int x = 1; x < 32; x <<= 1) qn = fmaxf(qn, __builtin_bit_cast(float, __builtin_amdgcn_ds_bpermute((lane ^ x) << 2, __builtin_bit_cast(int, qn))));
  float* xb = (float*)(lds + 143360 + 128) + par * 16;
  if (lane == 0) xb[wid] = qn;
  __syncthreads();
  float Bq = 0.f;
#pragma unroll
  for (int i = 0; i < 8; ++i) Bq = fmaxf(Bq, xb[i]);
  int jlo, n;
  { const float dmax = (TSKIP + Bq + 0.05f) / (-nslope);
    const float klo = (float)q0 - dmax, khi = (float)(q0 + 127) + dmax;
    int a0 = klo <= 0.f ? 0 : (int)(klo * (1.f / 64.f)); int a1 = khi >= (float)(SEQ - 1) ? NT - 1 : (int)(khi * (1.f / 64.f));
    if (((a1 - a0 + 1) & 1) != 0) { if (a0 > 0) --a0; else ++a1; }
    jlo = __builtin_amdgcn_readfirstlane(a0); n = __builtin_amdgcn_readfirstlane(a1 - a0 + 1); }
  const int dt = 2 * qb, nR = jlo + n - dt;
#define TILE(jj) ((jj) < nR ? dt + (jj) : dt - 1 - ((jj) - nR))
  float m_run = -1e30f; int live = 0;
#pragma unroll
  for (int i = 0; i < 4; ++i) stg[i] = ld8(Kh + (long)(TILE(g) * KVBLK + sr + 16 * i) * LD + sc);
#pragma unroll
  for (int i = 0; i < 4; ++i) *(bf16x8*)(K_lds + g * SHM_K + KSWZ(sr + 16 * i, sc * 2)) = stg[i];
  if (!g || n > 2) {
#pragma unroll
    for (int i = 0; i < 4; ++i) stg[i] = ld8(Tsrc + (long)(TILE(g ? 2 : 0) * KVBLK + 16 * i) * LD); }
  __syncthreads();
  if (g == 1) { __builtin_amdgcn_s_setprio(1); __syncthreads(); }
#define RESC_() do { if (__any(alpha < 1.f)) { if (hi == 0) al_l[r32] = alpha; asm volatile("s_waitcnt lgkmcnt(0)" ::: "memory"); \
    _Pragma("unroll") for (int d = 0; d < 4; ++d) _Pragma("unroll") for (int r = 0; r < 16; ++r) o[d][r] *= al_l[crow(r, hi)]; } } while (0)
#define PP_STEP(j, PAR) do { \
    qkt_c(p0, p1, Kmine + (PAR) * SHM_K, qr, negm, r32, hi); \
    if (live) pv_d0(o, vb0 + (1 - (PAR)) * (int)SHM_V, pa0, pa1, pa2, pa3); \
    __syncthreads(); \
    live = __builtin_amdgcn_readfirstlane((int)softmax_pp(p0, p1, m_reg, l_reg, negm, alpha, m_run, qposf - (float)(TILE(j) * KVBLK), nslope, pa0, pa1, pa2, pa3)); \
    RESC_(); \
    { const int wt = g ? (j) + 2 : (j); \
      if (wt < n) { _Pragma("unroll") for (int i = 0; i < 4; ++i) *(bf16x8*)(lds + woff[i] + (PAR) * 16384) = stg[i]; } \
      if (wt + 1 < n) { const int tn = TILE(wt + 1); _Pragma("unroll") for (int i = 0; i < 4; ++i) stg[i] = ld8(Tsrc + (long)(tn * KVBLK + 16 * i) * LD); } } \
    __syncthreads(); } while (0)
  _Pragma("nounroll") for (int j = 0; j < n; j += 2) { PP_STEP(j, 0); PP_STEP(j + 1, 1); }
  if (live) pv_d0(o, vb0 + (int)SHM_V, pa0, pa1, pa2, pa3);
  if (g == 0) __syncthreads();
  __builtin_amdgcn_s_setprio(0);
#undef PP_STEP
#undef RESC_
#undef TILE
  if (hi == 0) li_l[r32] = l_reg; asm volatile("s_waitcnt lgkmcnt(0)" ::: "memory");
#pragma unroll
  for (int r = 0; r < 16; ++r) { const float rl = __builtin_amdgcn_rcpf(li_l[crow(r, hi)]);
#pragma unroll
    for (int d0 = 0; d0 < 4; ++d0) o[d0][r] *= rl; }
  float* xs = (float*)(lds + SHM_X) + w4 * 4096 + lane;
  const size_t row0 = (size_t)(rowbase + q0 + w4 * QBLK + 4 * hi);
  unsigned gofs = (unsigned)((row0 * 2048 + h * 128 + r32) * 2), aofs = (unsigned)((row0 * 1024 + h * 128 + r32) * 2);
  asm volatile("" : "+v"(gofs), "+v"(aofs));
#define GATE_LD(ro_, col_) (*(const unsigned short*)((const char*)GBp + (gofs + (unsigned)(((ro_) * 2048 + (col_)) * 2))))
#define MIX_ST(ro_, col_, v_) (*(unsigned short*)((char*)AOp + (aofs + (unsigned)(((ro_) * 1024 + (col_)) * 2))) = (v_))
  float* pgs = (float*)lds + w4 * 4096 + lane;
  if (g == 1) {
    unsigned gate16[64];
#pragma unroll
    for (int r = 0; r < 16; ++r)
#pragma unroll
      for (int d0 = 0; d0 < 4; ++d0) gate16[r * 4 + d0] = GATE_LD((r & 3) + 8 * (r >> 2), 1024 + d0 * 32);
    bf16x8 pf[8];
    { const bf16_t* pr = PLDp + (size_t)(rowbase + q0 + w4 * QBLK + r32) * 512 + (h >> 1) * 128 + hi * 8;
#pragma unroll
      for (int ks = 0; ks < 8; ++ks) pf[ks] = ld8(pr + ks * 16); }
#pragma unroll
    for (int d0 = 0; d0 < 4; ++d0)
#pragma unroll
      for (int r = 0; r < 16; ++r) xs[(d0 * 16 + r) * 64] = o[d0][r];
    __syncthreads();
    const bf16_t* wpb = WPLp + (size_t)((h >> 1) * 256 + (h & 1) * 128 + r32) * 128 + hi * 8;
#pragma unroll
    for (int dp = 0; dp < 2; ++dp) {
      bf16x8 wp[2][8];
#pragma unroll
      for (int e = 0; e < 2; ++e)
#pragma unroll
        for (int ks = 0; ks < 8; ++ks) wp[e][ks] = ld8(wpb + (dp * 2 + e) * 32 * 128 + ks * 16);
#pragma unroll
      for (int e = 0; e < 2; ++e) { const int d0 = dp * 2 + e; f32x16 acc = f32x16{};
#pragma unroll
        for (int ks = 0; ks < 8; ++ks) acc = __builtin_amdgcn_mfma_f32_32x32x16_bf16(pf[ks], wp[e][ks], acc, 0, 0, 0);
#pragma unroll
        for (int r = 0; r < 16; ++r) pgs[(d0 * 16 + r) * 64] = sigm_(__uint_as_float(gate16[r * 4 + d0] << 16)) * acc[r]; }
    }
    __syncthreads();
  } else {
    unsigned gate16[64];
#pragma unroll
    for (int r = 0; r < 16; ++r)
#pragma unroll
      for (int d0 = 0; d0 < 4; ++d0) gate16[r * 4 + d0] = GATE_LD((r & 3) + 8 * (r >> 2), d0 * 32);
    __syncthreads();
    float ss[16];
#pragma unroll
    for (int r = 0; r < 16; ++r) ss[r] = 0.f;
#pragma unroll
    for (int d0 = 0; d0 < 4; ++d0)
#pragma unroll
      for (int r = 0; r < 16; ++r) { const float v = o[d0][r] - lam * xs[(d0 * 16 + r) * 64]; o[d0][r] = v; ss[r] += v * v; }
#pragma unroll
    for (int r = 0; r < 16; ++r) { float s = ss[r];
#pragma unroll
      for (int x = 1; x < 32; x <<= 1) s += __builtin_bit_cast(float, __builtin_amdgcn_ds_bpermute((lane ^ x) << 2, __builtin_bit_cast(int, s)));
      ss[r] = 1.0f / sqrtf(s * (1.0f / 128.0f) + 1e-5f); }
    float sg[4];
#pragma unroll
    for (int d0 = 0; d0 < 4; ++d0) sg[d0] = sub_g[d0 * 32 + r32] * 0.8f;
#pragma unroll
    for (int r = 0; r < 16; ++r)
#pragma unroll
      for (int d0 = 0; d0 < 4; ++d0) { const float ga = __uint_as_float(gate16[r * 4 + d0] << 16); o[d0][r] = o[d0][r] * ss[r] * sg[d0] * sigm_(ga); }
    __syncthreads();
#pragma unroll
    for (int d0 = 0; d0 < 4; ++d0)
#pragma unroll
      for (int r = 0; r < 16; ++r) { const int ro = (r & 3) + 8 * (r >> 2);
        const float val = o[d0][r] + pgs[(d0 * 16 + r) * 64];
        unsigned u = __float_as_uint(val); u = (u + 0x7fffu + ((u >> 16) & 1u)) >> 16;
        MIX_ST(ro, d0 * 32, (unsigned short)u); }
  }
#undef GATE_LD
#undef MIX_ST
}
#undef SBAR
}

#define GAS __attribute__((address_space(1)))
#define LAS __attribute__((address_space(3)))
typedef unsigned short bf16;
typedef unsigned v4u __attribute__((ext_vector_type(4)));
typedef float f32x4 __attribute__((ext_vector_type(4)));
constexpr int NWAVES = 8;
constexpr size_t MiB = 1u << 20;
constexpr size_t WS_MOD = 1 * MiB;
constexpr size_t WS_MODP = 2 * MiB;
constexpr size_t WS_WIN = 14 * MiB;
constexpr size_t WS_WOUT = 25 * MiB;
constexpr size_t WS_WF1 = 27 * MiB;
constexpr size_t WS_WF2 = 38 * MiB;
constexpr size_t WS_WPL = 44 * MiB;
constexpr size_t WS_H = 80 * MiB;
constexpr size_t WS_PLD = 208 * MiB;
constexpr size_t WS_Q = 272 * MiB, WS_K = 400 * MiB, WS_V = 528 * MiB, WS_U = 656 * MiB, WS_G = 720 * MiB;
constexpr size_t WS_ACT = 272 * MiB;
constexpr size_t WS_END = 976 * MiB;
constexpr int LDS_BYTES = 147456;

#define LDS_WAIT() asm volatile("s_waitcnt lgkmcnt(0)" ::: "memory")
__device__ __forceinline__ unsigned f2bf(float f) { unsigned u = __builtin_bit_cast(unsigned, f); return (u + 0x7fffu + ((u >> 16) & 1u)) >> 16; }
__device__ __forceinline__ unsigned pk2(float lo, float hi) { return f2bf(lo) | (f2bf(hi) << 16); }
__device__ __forceinline__ float wave_sum(float v, int lane) {
#pragma unroll
    for (int o = 1; o < 64; o <<= 1) v += __builtin_bit_cast(float, __builtin_amdgcn_ds_bpermute((lane ^ o) << 2, __builtin_bit_cast(int, v)));
    return v;
}
__device__ __forceinline__ void p0_transpose_item(const float* W, int K, int N, bf16* WT, int mode, LAS float* scr, int item, int lane, const float* nscale = nullptr) {
    const int nblk = N / 32, kb = item / nblk, nb = item % nblk, k0 = 64 * kb, n0 = 32 * nb;
    int d0 = n0;
    if (mode == 1) { d0 = (n0 < DFF) ? (256 * (n0 >> 7) + (n0 & 127)) : (256 * ((n0 - DFF) >> 7) + 128 + ((n0 - DFF) & 127)); }
    const float nsc = nscale ? nscale[n0 + (lane & 31)] : 1.0f;
    float wv[32];
#pragma unroll
    for (int i = 0; i < 32; ++i) { const int kk = 2 * i + (lane >> 5); wv[i] = __builtin_nontemporal_load(&W[(size_t)(k0 + kk) * N + n0 + (lane & 31)]); }
#pragma unroll
    for (int i = 0; i < 32; ++i) { const int kk = 2 * i + (lane >> 5); scr[kk * 33 + (lane & 31)] = wv[i] * nsc; }
    LDS_WAIT(); asm volatile("" ::: "memory");
    const int c = lane & 7;
#pragma unroll
    for (int j = 0; j < 4; ++j) { const int n = (lane >> 3) + 8 * j; const LAS float* s = scr + (8 * c) * 33 + n;
        v4u o; o.x = pk2(s[0 * 33], s[1 * 33]); o.y = pk2(s[2 * 33], s[3 * 33]); o.z = pk2(s[4 * 33], s[5 * 33]); o.w = pk2(s[6 * 33], s[7 * 33]);
        *(GAS v4u*)(WT + (size_t)(d0 + n) * K + k0 + 8 * c) = o; }
    LDS_WAIT(); asm volatile("" ::: "memory");
}
__device__ __forceinline__ void p0_mod_item(const float* c, const float* w_ada, float* part, LAS float* scr, int item, int lane) {
    const int cgp = item % 96, kc = item / 96, j = cgp * 64 + lane, k0 = kc * 64;
    { float cv[32];
#pragma unroll
      for (int b = 0; b < 32; ++b) cv[b] = c[b * 1024 + k0 + lane];
#pragma unroll
      for (int b = 0; b < 32; ++b) scr[b * 64 + lane] = cv[b] / (1.0f + __expf(-cv[b])); }
    LDS_WAIT(); asm volatile("" ::: "memory");
    float acc[32];
#pragma unroll
    for (int b = 0; b < 32; ++b) acc[b] = 0.f;
    for (int kk = 0; kk < 64; kk += 16) {
        float w[16];
#pragma unroll
        for (int i = 0; i < 16; ++i) w[i] = __builtin_nontemporal_load(&w_ada[(size_t)(k0 + kk + i) * NMOD + j]);
#pragma unroll
        for (int b = 0; b < 32; ++b) { const LAS f32x4* sp = (const LAS f32x4*)(scr + b * 64 + kk); const f32x4 s0 = sp[0], s1 = sp[1], s2 = sp[2], s3 = sp[3];
            acc[b] += ((s0.x * w[0] + s0.y * w[1] + s0.z * w[2] + s0.w * w[3]) + (s1.x * w[4] + s1.y * w[5] + s1.z * w[6] + s1.w * w[7]))
                    + ((s2.x * w[8] + s2.y * w[9] + s2.z * w[10] + s2.w * w[11]) + (s3.x * w[12] + s3.y * w[13] + s3.z * w[14] + s3.w * w[15])); }
    }
#pragma unroll
    for (int b = 0; b < 32; ++b) part[(size_t)(kc * 32 + b) * NMOD + j] = acc[b];
    LDS_WAIT(); asm volatile("" ::: "memory");
}

#define XB_TMO      128
#define XB_XCNT(j)  (256  + 64 * (j))
#define XB_XSUB(j)  (1280 + 64 * (j))
#define XB_XGEN(j)  (2304 + 64 * (j))
#define XB_TOP      3328
#define XB_TOPGEN   3392
#define XCD_BAR_WORDS 3456
#define XB_SPIN_CAP (1u << 18)

__device__ __forceinline__ unsigned xb_ld(unsigned* p)              { return __hip_atomic_load(p, __ATOMIC_RELAXED, __HIP_MEMORY_SCOPE_AGENT); }
__device__ __forceinline__ unsigned xb_add(unsigned* p, unsigned v) { return __hip_atomic_fetch_add(p, v, __ATOMIC_RELAXED, __HIP_MEMORY_SCOPE_AGENT); }
__device__ __forceinline__ unsigned xb_xcc_id() { return (unsigned)__builtin_amdgcn_s_getreg((3 << 11) | 20) & 0xFu; }
#define XB_SPIN(cond, bar) do { unsigned _sp = 0; while (cond) { __builtin_amdgcn_s_sleep(1); \
    if ((++_sp & 255u) == 0u) { if (xb_ld(&(bar)[XB_TMO])) break; if (_sp > XB_SPIN_CAP) { atomicAdd(&(bar)[XB_TMO], 1u); break; } } } } while (0)

struct XcdBarrier {
    unsigned* bar; unsigned x;
    volatile LAS unsigned* st;
};

__device__ __forceinline__ XcdBarrier xcd_barrier_post(unsigned* bar, volatile LAS unsigned* st) {
    XcdBarrier b; b.bar = bar; b.x = xb_xcc_id(); b.st = st;
    if (threadIdx.x == 0) (void)xb_add(&bar[XB_XCNT(b.x)], 1u);
    return b;
}
__device__ __forceinline__ void xcd_barrier_complete(unsigned* bar, unsigned x, unsigned& nloc, unsigned& nx) {
    const unsigned G = gridDim.x * gridDim.y * gridDim.z;
    unsigned sum, cnt, mine, sp = 0u;
    for (;;) {
        sum = 0u; cnt = 0u; mine = 0u;
#pragma unroll
        for (unsigned j = 0; j < 16; ++j) { const unsigned c = xb_ld(&bar[XB_XCNT(j)]); sum += c; cnt += (c > 0u) ? 1u : 0u; mine = (j == x) ? c : mine; }
        if (sum == G) break;
        __builtin_amdgcn_s_sleep(1);
        if ((++sp & 255u) == 0u) { if (xb_ld(&bar[XB_TMO])) break; if (sp > XB_SPIN_CAP) { atomicAdd(&bar[XB_TMO], 1u); break; } }
    }
    nloc = mine > 0u ? mine : 1u; nx = cnt > 0u ? cnt : 1u;
}

__device__ __forceinline__ void xcd_barrier(const XcdBarrier& b) {
    asm volatile("s_waitcnt vmcnt(0)" ::: "memory");
    __syncthreads();
    if (threadIdx.x == 0) {
        unsigned* bar = b.bar;
        __builtin_amdgcn_s_waitcnt(0);
        unsigned nloc = b.st[0], nx = b.st[1];
        if (nloc == 0u) { xcd_barrier_complete(bar, b.x, nloc, nx); b.st[0] = nloc; b.st[1] = nx; }
        const unsigned old = xb_add(&bar[XB_XSUB(b.x)], 1u);
        const unsigned gen = old / nloc;
        if (old + 1u == (gen + 1u) * nloc) {
            __builtin_amdgcn_fence(__ATOMIC_RELEASE, "agent");
            asm volatile("s_waitcnt vmcnt(0)" ::: "memory");
            const unsigned og = xb_add(&bar[XB_TOP], 1u);
            const unsigned tg = og / nx;
            if (og + 1u == (tg + 1u) * nx) xb_add(&bar[XB_TOPGEN], 1u);
            else XB_SPIN(xb_ld(&bar[XB_TOPGEN]) == tg, bar);
            __builtin_amdgcn_fence(__ATOMIC_ACQUIRE, "agent");
            xb_add(&bar[XB_XGEN(b.x)], 1u);
            asm volatile("s_waitcnt vmcnt(0)" ::: "memory");
        } else {
            XB_SPIN(xb_ld(&bar[XB_XGEN(b.x)]) == gen, bar);
            __builtin_amdgcn_fence(__ATOMIC_ACQUIRE, "agent");
            asm volatile("s_waitcnt vmcnt(0)" ::: "memory");
        }
    }
    __syncthreads();
}

struct Args { const float* in[19]; float* out; unsigned char* ws; };
#define PHASE_IDS int t__ = threadIdx.x; asm volatile("" : "+v"(t__)); const int tid = t__, lane = tid & 63, wave = __builtin_amdgcn_readfirstlane(tid >> 6), gw = vcu * NWAVES + wave; (void)tid; (void)lane; (void)wave; (void)gw

__global__ void __launch_bounds__(NWAVES * 64) mega_fwd(Args args) {
    extern __shared__ __attribute__((aligned(16))) unsigned char lds[];
    cg::grid_group grid = cg::this_grid();
    const int tid = threadIdx.x, lane = tid & 63, wave = __builtin_amdgcn_readfirstlane(tid >> 6);
    const int G = gridDim.x, bx = blockIdx.x; int vcu = bx, gc = bx;
    const int NGW = G * NWAVES;
    unsigned char* ws = args.ws;
    unsigned* ctl = (unsigned*)ws;
    volatile LAS unsigned* misc = (volatile LAS unsigned*)((LAS unsigned char*)lds + 143360);
    if (tid < 16) misc[tid] = 0u;
    __syncthreads();
    const XcdBarrier xbar = xcd_barrier_post((unsigned*)(ws + 16384), misc + 8);
    if (tid == 0) { const unsigned xcc = (unsigned)__builtin_amdgcn_s_getreg((3 << 11) | 20) & 0xFu;
        misc[0] = xcc; misc[1] = __hip_atomic_fetch_add(ctl + 64 * xcc, 1u, __ATOMIC_RELAXED, __HIP_MEMORY_SCOPE_AGENT); }
    const float* x = args.in[0]; const float* cvec = args.in[1]; const float* w_ada = args.in[2]; const float* b_ada = args.in[3]; const float* w_in = args.in[4];
    const float* lq1 = args.in[5]; const float* lk1 = args.in[6]; const float* lq2 = args.in[7]; const float* lk2 = args.in[8]; const float* sub_g = args.in[9];
    const float* w_pool = args.in[10]; const float* pool_scale = args.in[11]; const float* w_out = args.in[12]; const float* ln1_g = args.in[13]; const float* ln1_b = args.in[14];
    const float* w_f1 = args.in[15]; const float* w_f2 = args.in[16]; const float* ln2_g = args.in[17]; const float* ln2_b = args.in[18];
    float* out = args.out;
    float* MOD = (float*)(ws + WS_MOD); float* MODP = (float*)(ws + WS_MODP);
    bf16* Wt_in = (bf16*)(ws + WS_WIN); bf16* Wt_out = (bf16*)(ws + WS_WOUT); bf16* Wt_f1 = (bf16*)(ws + WS_WF1); bf16* Wt_f2 = (bf16*)(ws + WS_WF2); bf16* Wt_pl = (bf16*)(ws + WS_WPL);
    bf16* HB = (bf16*)(ws + WS_H); bf16* PLD = (bf16*)(ws + WS_PLD);
    bf16* QB = (bf16*)(ws + WS_Q); bf16* KB = (bf16*)(ws + WS_K); bf16* VB = (bf16*)(ws + WS_V); bf16* UB = (bf16*)(ws + WS_U); bf16* GB = (bf16*)(ws + WS_G);
    bf16* ACT = (bf16*)(ws + WS_ACT);
    bf16* Y1 = (bf16*)(ws + WS_Q); bf16* Y2 = (bf16*)(ws + WS_G);
    unsigned* NRMK = (unsigned*)(ws + 8192);

    {
        PHASE_IDS;
        LAS float* scr = (LAS float*)((LAS unsigned char*)lds + wave * 16384);
        constexpr int I_IN = 16 * 176, I_OUT = 16 * 32, I_F1 = 16 * 176, I_F2 = 44 * 32, I_PL = 64, I_MOD = 96 * 16;
        constexpr int NITEMS = I_IN + I_OUT + I_F1 + I_F2 + I_PL + I_MOD;
        for (int it = gw; it < NITEMS; it += NGW) {
            int r = it;
            if (r < I_MOD) { p0_mod_item(cvec, w_ada, MODP, scr, r, lane); continue; } r -= I_MOD;
            if (r < I_IN) { p0_transpose_item(w_in, D, INC, Wt_in, 0, scr, r, lane); continue; } r -= I_IN;
            if (r < I_OUT) { p0_transpose_item(w_out, D, D, Wt_out, 0, scr, r, lane); continue; } r -= I_OUT;
            if (r < I_F1) { p0_transpose_item(w_f1, D, 2 * DFF, Wt_f1, 1, scr, r, lane); continue; } r -= I_F1;
            if (r < I_F2) { p0_transpose_item(w_f2, DFF, D, Wt_f2, 0, scr, r, lane); continue; } r -= I_F2;
            { const int g = r >> 4; p0_transpose_item(w_pool + (size_t)g * 128 * 256, 128, 256, Wt_pl + (size_t)g * 256 * 128, 0, scr, r & 15, lane, pool_scale + g * 256); }
        }
    }
    if (gridDim.y > 1) grid.sync();
    xcd_barrier(xbar);
    {
        if (threadIdx.x < 64) {
            const unsigned l_ = threadIdx.x, cj = l_ < 16u ? __hip_atomic_load(ctl + 64 * l_, __ATOMIC_RELAXED, __HIP_MEMORY_SCOPE_AGENT) : 0u;
            const unsigned xcc = misc[0], rank = misc[1]; unsigned pre = 0; bool even8 = true;
#pragma unroll
            for (int j = 0; j < 16; ++j) { const unsigned c_ = (unsigned)__builtin_amdgcn_readlane((int)cj, j);
                if ((unsigned)j < xcc) pre += c_; if (j < 8 ? (c_ * 8u != (unsigned)G) : (c_ != 0u)) even8 = false; }
            if (l_ == 0) { misc[2] = pre + rank; misc[3] = even8 ? rank * 8u + xcc : (unsigned)bx; } }
        __syncthreads();
        vcu = (int)misc[2]; gc = (int)misc[3];
        vcu = __builtin_amdgcn_readfirstlane(vcu); gc = __builtin_amdgcn_readfirstlane(gc);
    }

    {
        PHASE_IDS;
        LAS float* shsc = (LAS float*)lds;
        for (int p = vcu; p < MROWS / 256; p += G) {
            const int b = p >> 3, k8 = p & 7;
            __syncthreads();
            { float sv[5];
#pragma unroll
              for (int i = 0; i < 5; ++i) { const int j = tid + i * NWAVES * 64; const int col = j < 2048 ? j : 2048 + 512 * k8 + (j - 2048); float s = b_ada[col];
#pragma unroll
                  for (int kc = 0; kc < 16; ++kc) s += MODP[(size_t)(kc * 32 + b) * NMOD + col];
                  sv[i] = s; }
#pragma unroll
              for (int i = 0; i < 5; ++i) { const int j = tid + i * NWAVES * 64; const int col = j < 2048 ? j : 2048 + 512 * k8 + (j - 2048);
                  if (j < 2048) shsc[j] = sv[i]; else MOD[(size_t)b * NMOD + col] = sv[i]; } }
            __syncthreads();
            for (int rr = wave; rr < 256; rr += NWAVES) {
                const size_t row = (size_t)p * 256 + rr;
                const GAS f32x4* xr = (const GAS f32x4*)(x + row * D) + lane;
                f32x4 v[4]; float s = 0.f;
#pragma unroll
                for (int j = 0; j < 4; ++j) { v[j] = __builtin_nontemporal_load(&xr[64 * j]); s += (v[j].x + v[j].y) + (v[j].z + v[j].w); }
                const float mean = wave_sum(s, lane) * (1.f / D); float s2 = 0.f;
#pragma unroll
                for (int j = 0; j < 4; ++j) { v[j] = v[j] - mean; s2 += (v[j].x * v[j].x + v[j].y * v[j].y) + (v[j].z * v[j].z + v[j].w * v[j].w); }
                const float rstd = 1.f / sqrtf(wave_sum(s2, lane) * (1.f / D) + LN_EPS);
                GAS unsigned long long* o8 = (GAS unsigned long long*)(HB + row * D) + lane;
#pragma unroll
                for (int j = 0; j < 4; ++j) { const f32x4 sh = *(const LAS f32x4*)(shsc + 256 * j + 4 * lane), sc = *(const LAS f32x4*)(shsc + 1024 + 256 * j + 4 * lane);
                    const f32x4 y = v[j] * rstd * (sc + 1.0f) + sh;
                    o8[64 * j] = (unsigned long long)pk2(y.x, y.y) | ((unsigned long long)pk2(y.z, y.w) << 32); }
            }
        }
    }
    xcd_barrier(xbar);

    {
        PHASE_IDS;
        pg8::Gemm g{HB, Wt_in, MROWS, INC, D, D, D, 0}; pg8::StaticOrder S; S.init(MROWS, INC, G, gc);
        pg8::EpiProj E{QB, KB, VB, UB, GB, QSCALE, NRMK};
        pg8::gemm_phase<pg8::EpiProj, pg8::StaticOrder, true, true>((LAS unsigned char*)lds, g, S, E);
    }
    xcd_barrier(xbar);

    {
        PHASE_IDS;
        for (int chunk = gw; chunk < MROWS / 32; chunk += NGW) {
            const int row0 = chunk * 32, t0 = row0 & (SEQ - 1), gi = lane >> 4, half = 1 << gi;
            const bf16* base = UB + (size_t)(row0 - t0) * PIN + lane * 8;
            float s[8];
#pragma unroll
            for (int e = 0; e < 8; ++e) s[e] = 0.f;
#define ACC_ROW(tau, sgn) do { const v4u w_ = *(const v4u*)(base + (size_t)(tau) * PIN); \
                s[0] += (sgn) * pg8::bf_lo(w_.x); s[1] += (sgn) * pg8::bf_hi(w_.x); s[2] += (sgn) * pg8::bf_lo(w_.y); s[3] += (sgn) * pg8::bf_hi(w_.y); \
                s[4] += (sgn) * pg8::bf_lo(w_.z); s[5] += (sgn) * pg8::bf_hi(w_.z); s[6] += (sgn) * pg8::bf_lo(w_.w); s[7] += (sgn) * pg8::bf_hi(w_.w); } while (0)
            { const int lo = (t0 - half) > 0 ? (t0 - half) : 0, hi = (t0 + half) < SEQ ? (t0 + half) : SEQ;
              v4u w16[16];
#pragma unroll
              for (int q = 0; q < 16; ++q) w16[q] = *(const v4u*)(base + (size_t)((lo + q) < hi ? (lo + q) : lo) * PIN);
#pragma unroll
              for (int q = 0; q < 16; ++q) { const float m_ = (lo + q) < hi ? 1.0f : 0.0f; const v4u a_ = w16[q];
                  s[0] += m_ * pg8::bf_lo(a_.x); s[1] += m_ * pg8::bf_hi(a_.x); s[2] += m_ * pg8::bf_lo(a_.y); s[3] += m_ * pg8::bf_hi(a_.y);
                  s[4] += m_ * pg8::bf_lo(a_.z); s[5] += m_ * pg8::bf_hi(a_.z); s[6] += m_ * pg8::bf_lo(a_.w); s[7] += m_ * pg8::bf_hi(a_.w); } }
            for (int tt = 0; tt < 32; tt += 4) {
                v4u ut[4], wa[4], wr[4]; float ma[4], mr[4];
#pragma unroll
                for (int q = 0; q < 4; ++q) { const int t = t0 + tt + q, ta = t + half, tr = t - half;
                    ut[q] = *(const v4u*)(base + (size_t)t * PIN);
                    ma[q] = ta < SEQ ? 1.0f : 0.0f; wa[q] = *(const v4u*)(base + (size_t)(ta < SEQ ? ta : SEQ - 1) * PIN);
                    mr[q] = tr >= 0 ? -1.0f : 0.0f; wr[q] = *(const v4u*)(base + (size_t)(tr >= 0 ? tr : 0) * PIN); }
#pragma unroll
                for (int q = 0; q < 4; ++q) { const int t = t0 + tt + q, lo = (t - half) > 0 ? (t - half) : 0, hi = (t + half) < SEQ ? (t + half) : SEQ;
                    const float inv = 1.0f / (float)(hi - lo); const v4u u_ = ut[q];
                    v4u o; o.x = pk2(s[0] * inv - pg8::bf_lo(u_.x), s[1] * inv - pg8::bf_hi(u_.x)); o.y = pk2(s[2] * inv - pg8::bf_lo(u_.y), s[3] * inv - pg8::bf_hi(u_.y));
                    o.z = pk2(s[4] * inv - pg8::bf_lo(u_.z), s[5] * inv - pg8::bf_hi(u_.z)); o.w = pk2(s[6] * inv - pg8::bf_lo(u_.w), s[7] * inv - pg8::bf_hi(u_.w));
                    *(v4u*)(PLD + (size_t)(row0 + tt + q) * PIN + lane * 8) = o;
                    { const v4u a_ = wa[q]; const float m_ = ma[q];
                      s[0] += m_ * pg8::bf_lo(a_.x); s[1] += m_ * pg8::bf_hi(a_.x); s[2] += m_ * pg8::bf_lo(a_.y); s[3] += m_ * pg8::bf_hi(a_.y);
                      s[4] += m_ * pg8::bf_lo(a_.z); s[5] += m_ * pg8::bf_hi(a_.z); s[6] += m_ * pg8::bf_lo(a_.w); s[7] += m_ * pg8::bf_hi(a_.w); }
                    { const v4u r_ = wr[q]; const float m_ = mr[q];
                      s[0] += m_ * pg8::bf_lo(r_.x); s[1] += m_ * pg8::bf_hi(r_.x); s[2] += m_ * pg8::bf_lo(r_.y); s[3] += m_ * pg8::bf_hi(r_.y);
                      s[4] += m_ * pg8::bf_lo(r_.z); s[5] += m_ * pg8::bf_hi(r_.z); s[6] += m_ * pg8::bf_lo(r_.w); s[7] += m_ * pg8::bf_hi(r_.w); } }
            }
#undef ACC_ROW
        }
        xcd_barrier(xbar);
        const float lam = __expf(wave_sum(lq1[lane] * lk1[lane], lane)) - __expf(wave_sum(lq2[lane] * lk2[lane], lane)) + 0.2f;
        for (int i = 0, U = vcu; U < BATCH * NH * (SEQ / 128); U += G, ++i) {
            int b = U >> 7, h = (U >> 4) & 7, qb = U & 15;
            if (G == 256) { const int gi = vcu >> 4; h = (gi + i) & 7; b = i * 2 + (gi >> 3); qb = (vcu + i) & 15; }
            attn::attn_unit_pp(b, h, qb, i & 1, QB, KB, VB, GB, HB, PLD, Wt_pl, lam, sub_g, NRMK, (char*)lds);
        }
        __syncthreads();
    }
    xcd_barrier(xbar);

    {
        PHASE_IDS;
        pg8::Gemm g{HB, Wt_out, MROWS, D, D, D, D, 0}; pg8::StaticOrder S; S.init(MROWS, D, G, gc);
        pg8::EpiGate E{Y1, MOD + 2048};
        pg8::gemm_phase<pg8::EpiGate, pg8::StaticOrder, true, true>((LAS unsigned char*)lds, g, S, E);
    }
    xcd_barrier(xbar);

    {
        PHASE_IDS;
        f32x4 g1v[4], b1v[4];
#pragma unroll
        for (int j = 0; j < 4; ++j) { g1v[j] = *(const f32x4*)(ln1_g + 256 * j + 4 * lane); b1v[j] = *(const f32x4*)(ln1_b + 256 * j + 4 * lane); }
    for (int row = gw; row < MROWS; row += NGW) {
        const int b = row >> 11; const float* mb = MOD + (size_t)b * NMOD;
        GAS f32x4* zr = (GAS f32x4*)(out + (size_t)row * D) + lane;
        const GAS f32x4* xr = (const GAS f32x4*)(x + (size_t)row * D) + lane;
        const GAS unsigned long long* yr = (const GAS unsigned long long*)(Y1 + (size_t)row * D) + lane;
        f32x4 v[4]; float s = 0.f;
#pragma unroll
        for (int j = 0; j < 4; ++j) { const f32x4 xv = __builtin_nontemporal_load(&xr[64 * j]); const unsigned long long yy = __builtin_nontemporal_load(&yr[64 * j]); const unsigned ylo = (unsigned)yy, yhi = (unsigned)(yy >> 32);
            v[j] = xv * ALPHA + (f32x4){pg8::bf_lo(ylo), pg8::bf_hi(ylo), pg8::bf_lo(yhi), pg8::bf_hi(yhi)};
            s += (v[j].x + v[j].y) + (v[j].z + v[j].w); }
        float mean = wave_sum(s, lane) * (1.f / D), s2 = 0.f;
#pragma unroll
        for (int j = 0; j < 4; ++j) { v[j] = v[j] - mean; s2 += (v[j].x * v[j].x + v[j].y * v[j].y) + (v[j].z * v[j].z + v[j].w * v[j].w); }
        float rstd = 1.f / sqrtf(wave_sum(s2, lane) * (1.f / D) + LN_EPS);
        s = 0.f;
#pragma unroll
        for (int j = 0; j < 4; ++j) { const f32x4 gg = g1v[j], bb = b1v[j];
            v[j] = v[j] * rstd * gg + bb; __builtin_nontemporal_store(v[j], &zr[64 * j]); s += (v[j].x + v[j].y) + (v[j].z + v[j].w); }
        mean = wave_sum(s, lane) * (1.f / D); s2 = 0.f;
#pragma unroll
        for (int j = 0; j < 4; ++j) { v[j] = v[j] - mean; s2 += (v[j].x * v[j].x + v[j].y * v[j].y) + (v[j].z * v[j].z + v[j].w * v[j].w); }
        rstd = 1.f / sqrtf(wave_sum(s2, lane) * (1.f / D) + LN_EPS);
        GAS unsigned long long* o8 = (GAS unsigned long long*)(HB + (size_t)row * D) + lane;
#pragma unroll
        for (int j = 0; j < 4; ++j) { const f32x4 sh = *(const f32x4*)(mb + 3072 + 256 * j + 4 * lane), sc = *(const f32x4*)(mb + 4096 + 256 * j + 4 * lane);
            const f32x4 y = v[j] * rstd * (sc + 1.0f) + sh;
            o8[64 * j] = (unsigned long long)pk2(y.x, y.y) | ((unsigned long long)pk2(y.z, y.w) << 32); }
    }
    }
    xcd_barrier(xbar);

    {
        PHASE_IDS;
        pg8::Gemm g{HB, Wt_f1, MROWS, 2 * DFF, D, D, D, 0}; pg8::StaticOrder S; S.init(MROWS, 2 * DFF, G, gc);
        pg8::EpiSwiglu E{ACT};
        pg8::gemm_phase<pg8::EpiSwiglu, pg8::StaticOrder, true, true>((LAS unsigned char*)lds, g, S, E);
    }
    xcd_barrier(xbar);

    {
        PHASE_IDS;
        pg8::Gemm g{ACT, Wt_f2, MROWS, D, DFF, DFF, DFF, 0}; pg8::StaticOrder S; S.init(MROWS, D, G, gc);
        pg8::EpiGate E{Y2, MOD + 5120};
        pg8::gemm_phase<pg8::EpiGate, pg8::StaticOrder, true, true>((LAS unsigned char*)lds, g, S, E);
    }
    xcd_barrier(xbar);

    {
        PHASE_IDS;
        f32x4 g2v[4], b2v[4];
#pragma unroll
        for (int jj = 0; jj < 4; ++jj) { g2v[jj] = *(const f32x4*)(ln2_g + 256 * jj + 4 * lane); b2v[jj] = *(const f32x4*)(ln2_b + 256 * jj + 4 * lane); }
    for (int row = gw; row < MROWS; row += NGW) {
        GAS f32x4* zr = (GAS f32x4*)(out + (size_t)row * D) + lane;
        const GAS unsigned long long* yr = (const GAS unsigned long long*)(Y2 + (size_t)row * D) + lane;
        f32x4 v[4]; float s = 0.f;
#pragma unroll
        for (int j = 0; j < 4; ++j) { const f32x4 xv = __builtin_nontemporal_load(&zr[64 * j]); const unsigned long long yy = __builtin_nontemporal_load(&yr[64 * j]); const unsigned ylo = (unsigned)yy, yhi = (unsigned)(yy >> 32);
            v[j] = xv * ALPHA + (f32x4){pg8::bf_lo(ylo), pg8::bf_hi(ylo), pg8::bf_lo(yhi), pg8::bf_hi(yhi)};
            s += (v[j].x + v[j].y) + (v[j].z + v[j].w); }
        const float mean = wave_sum(s, lane) * (1.f / D); float s2 = 0.f;
#pragma unroll
        for (int j = 0; j < 4; ++j) { v[j] = v[j] - mean; s2 += (v[j].x * v[j].x + v[j].y * v[j].y) + (v[j].z * v[j].z + v[j].w * v[j].w); }
        const float rstd = 1.f / sqrtf(wave_sum(s2, lane) * (1.f / D) + LN_EPS);
#pragma unroll
        for (int j = 0; j < 4; ++j) { const f32x4 gg = g2v[j], bb = b2v[j];
            __builtin_nontemporal_store(v[j] * rstd * gg + bb, &zr[64 * j]); }
    }
    }
}

extern "C" void kernel_launch(void* const* d_in, const int* in_sizes, int n_in, void* d_out, int out_size, void* d_ws, size_t ws_size, hipStream_t stream) {
    static int grid = 0;
    if (grid == 0) {
        if (n_in != 19 || in_sizes[0] != MROWS * D || out_size != MROWS * D || ws_size < WS_END) {
            fprintf(stderr, "kernel_launch: shape mismatch: n_in %d in0 %d out %d ws %zu (need >= %zu)\n", n_in, n_in > 0 ? in_sizes[0] : -1, out_size, ws_size, (size_t)WS_END); grid = -1; return; }
        int dev = 0, cus = 0, per_cu = 0;
        if (hipGetDevice(&dev) != hipSuccess || hipDeviceGetAttribute(&cus, hipDeviceAttributeMultiprocessorCount, dev) != hipSuccess) { grid = -1; return; }
        if (hipFuncSetAttribute((const void*)mega_fwd, hipFuncAttributeMaxDynamicSharedMemorySize, LDS_BYTES) != hipSuccess) { fprintf(stderr, "kernel_launch: hipFuncSetAttribute failed\n"); grid = -1; return; }
        if (hipOccupancyMaxActiveBlocksPerMultiprocessor(&per_cu, (const void*)mega_fwd, NWAVES * 64, LDS_BYTES) != hipSuccess || per_cu < 1) { fprintf(stderr, "kernel_launch: occupancy query gave %d\n", per_cu); per_cu = 1; }
        (void)hipGetLastError();
        grid = cus * per_cu; if (grid > 256) grid = 256;
    }
    if (grid < 0) return;
    if (hipMemsetAsync(d_ws, 0, 32768, stream) != hipSuccess) { fprintf(stderr, "kernel_launch: memset failed\n"); return; }
    Args a{};
    for (int i = 0; i < 19; ++i) a.in[i] = (const float*)d_in[i];
    a.out = (float*)d_out; a.ws = (unsigned char*)d_ws;
    void* kargs[] = {&a};
    const hipError_t e = hipLaunchCooperativeKernel((const void*)mega_fwd, dim3(grid), dim3(NWAVES * 64), kargs, LDS_BYTES, stream);
    if (e != hipSuccess) fprintf(stderr, "kernel_launch: cooperative launch failed: %s (grid %d)\n", hipGetErrorString(e), grid);
}
```

```cpp
#include <hip/hip_runtime.h>
#include <hip/hip_cooperative_groups.h>
#include <cstdio>
#include <cstdint>
namespace cg = cooperative_groups;

constexpr int D = 1024, BATCH = 32, SEQ = 2048, MROWS = BATCH * SEQ, NH = 8, INC = 5632, DFF = 2816, PIN = 512, NMOD = 6144;
constexpr float ALPHA = 1.189207115002721f;
constexpr float LN_EPS = 1e-5f, RMS_EPS = 1e-5f;
constexpr float LOG2E = 1.4426950408889634f;
constexpr float QSCALE = 0.125f * LOG2E;

#ifndef HEADMAJOR
#define HEADMAJOR 1
#endif
namespace pg8 {
#define PG8_LAS __attribute__((address_space(3)))
typedef unsigned short bf16_t;
typedef short bf16x8 __attribute__((ext_vector_type(8)));
typedef float f32x4 __attribute__((ext_vector_type(4)));
typedef unsigned u32x4 __attribute__((ext_vector_type(4)));
constexpr int BM = 256, BK = 64, HALF = 128, HTB = HALF * BK * 2  , STAGE_BYTES = 8 * HTB, NXCD = 8, WGM = 8;

__host__ __device__ __forceinline__ int lds_byte(int r, int c) { const int st = (r >> 4) * 2 + (c >> 5), rr = r & 15, cc = c & 31, ob = rr * 64 + cc * 2; return st * 1024 + (ob ^ (((ob >> 9) & 1) << 5)); }
__host__ __device__ __forceinline__ void stage_rc(int b, int& R, int& C) { const int st = b / 1024, sb = b % 1024, swz = sb ^ (((sb >> 9) & 1) << 5); R = (st >> 1) * 16 + swz / 64; C = (st & 1) * 32 + (swz % 64) / 2; }
__host__ __device__ __forceinline__ int perm32(int rho) { const int n = rho >> 4, i = rho & 15; return 8 * (i >> 2) + 4 * n + (i & 3); }

struct Unit { int pm, pn; };
struct Gemm { const bf16_t* A; const bf16_t* Bt; int M, N, K, lda, ldb, apn; };

struct StaticOrder {
    int nM, nN, nwg, G, c;
    __host__ __device__ void init(int M, int N, int G_, int c_) { nM = M / BM; nN = N / BM; nwg = nM * nN; G = G_; c = c_; }
    __host__ __device__ bool next(int i, Unit& u) const {
        const long L = (long)i * G + c; if (L >= nwg) return false;
        int wgid = (int)L; { const int q = nwg / NXCD, r = nwg % NXCD, xcd = wgid % NXCD, off = wgid / NXCD; wgid = (xcd < r ? xcd * (q + 1) : r * (q + 1) + (xcd - r) * q) + off; }
        const int nig = WGM * nN, gid = wgid / nig, fm = gid * WGM, gsz = (nM - fm) < WGM ? (nM - fm) : WGM;
        u.pm = fm + ((wgid % nig) % gsz); u.pn = (wgid % nig) / gsz; return true;
    }
    __device__ __forceinline__ void a_ready(const Unit&) const {}
    __device__ __forceinline__ void done(const Unit&) const {}
};


__device__ __forceinline__ unsigned cvt_pk_bf16(float lo, float hi) { unsigned r; asm volatile("v_cvt_pk_bf16_f32 %0, %1, %2" : "=v"(r) : "v"(lo), "v"(hi)); return r; }
__device__ __forceinline__ float bf_lo(unsigned w) { return __uint_as_float(w << 16); }
__device__ __forceinline__ float bf_hi(unsigned w) { return __uint_as_float(w & 0xffff0000u); }
__device__ __forceinline__ float sigm(float x) { return __builtin_amdgcn_rcpf(1.0f + __builtin_amdgcn_exp2f(-1.4426950408889634f * x)); }

struct EpiProj {
    static constexpr bool PERM = true, AFTER_DRAIN = false;
    bf16_t *Q, *Kb, *V, *U, *G; float qscale; unsigned* nrmk;
    __device__ __forceinline__ void operator()(const f32x4 (&acc)[2][2][4][2], const Unit& u, int wr, int wc, int fr, int fq) const {
        const int pn = u.pn;
        if (pn >= 4 && pn < 8) {
            const int lane = fq * 16 + fr;
#pragma unroll
            for (int bj = 0; bj < 2; ++bj) { float mx = 0.f;
#pragma unroll
                for (int ai = 0; ai < 2; ++ai)
#pragma unroll
                    for (int m = 0; m < 4; ++m) { const f32x4 a = acc[ai][bj][m][0], c = acc[ai][bj][m][1];
                        float s = (a[0] * a[0] + a[1] * a[1]) + (a[2] * a[2] + a[3] * a[3]) + (c[0] * c[0] + c[1] * c[1]) + (c[2] * c[2] + c[3] * c[3]);
                        s += __builtin_bit_cast(float, __builtin_amdgcn_ds_bpermute((lane ^ 16) << 2, __builtin_bit_cast(int, s)));
                        s += __builtin_bit_cast(float, __builtin_amdgcn_ds_bpermute((lane ^ 32) << 2, __builtin_bit_cast(int, s)));
                        mx = fmaxf(mx, s); }
#pragma unroll
                for (int x = 1; x < 16; x <<= 1) mx = fmaxf(mx, __builtin_bit_cast(float, __builtin_amdgcn_ds_bpermute((lane ^ x) << 2, __builtin_bit_cast(int, mx))));
                if (lane == 0) atomicMax(nrmk + (((u.pm >> 3) * 8 + 2 * (pn - 4) + bj) * 2 + (wc >> 1)) * 2 + (wc & 1), __float_as_uint(mx)); }
        }
        if (HEADMAJOR && pn < 12) {
            bf16_t* base; int ct; float sc = 1.f;
            if (pn < 4) { base = Q; ct = pn; sc = qscale; } else if (pn < 8) { base = Kb; ct = pn - 4; } else { base = V; ct = pn - 8; }
            const int b = u.pm >> 3, t0 = (u.pm & 7) * BM + wr * 64 + fr;
#pragma unroll
            for (int bj = 0; bj < 2; ++bj) { bf16_t* hb = base + ((size_t)((b * 8 + 2 * ct + bj) * 2048 + t0)) * 128 + wc * 32 + 8 * fq;
#pragma unroll
                for (int ai = 0; ai < 2; ++ai)
#pragma unroll
                    for (int m = 0; m < 4; ++m) { const f32x4 v0 = acc[ai][bj][m][0] * sc, v1 = acc[ai][bj][m][1] * sc;
                        u32x4 w; w.x = cvt_pk_bf16(v0[0], v0[1]); w.y = cvt_pk_bf16(v0[2], v0[3]); w.z = cvt_pk_bf16(v1[0], v1[1]); w.w = cvt_pk_bf16(v1[2], v1[3]);
                        __builtin_nontemporal_store(w, (u32x4*)(hb + (ai * HALF + m * 16) * 128)); } }
        } else {
            bf16_t* base; int ld, ct; float sc = 1.f;
            if (pn < 4) { base = Q; ld = 1024; ct = pn; sc = qscale; } else if (pn < 8) { base = Kb; ld = 1024; ct = pn - 4; } else if (pn < 12) { base = V; ld = 1024; ct = pn - 8; }
            else if (pn < 14) { base = U; ld = 512; ct = pn - 12; } else { base = G; ld = 2048; ct = pn - 14; }
            const int row0 = u.pm * BM + wr * 64 + fr, col0 = ct * 256 + wc * 32 + 8 * fq;
#pragma unroll
            for (int ai = 0; ai < 2; ++ai)
#pragma unroll
                for (int m = 0; m < 4; ++m) { bf16_t* rowp = base + (size_t)(row0 + ai * HALF + m * 16) * ld + col0;
#pragma unroll
                    for (int bj = 0; bj < 2; ++bj) { const f32x4 v0 = acc[ai][bj][m][0] * sc, v1 = acc[ai][bj][m][1] * sc;
                        u32x4 w; w.x = cvt_pk_bf16(v0[0], v0[1]); w.y = cvt_pk_bf16(v0[2], v0[3]); w.z = cvt_pk_bf16(v1[0], v1[1]); w.w = cvt_pk_bf16(v1[2], v1[3]);
                        __builtin_nontemporal_store(w, (u32x4*)(rowp + bj * HALF)); } }
        }
    }
};
struct EpiGate {
    static constexpr bool PERM = true, AFTER_DRAIN = false;
    bf16_t* out; const float* gate;
    __device__ __forceinline__ void operator()(const f32x4 (&acc)[2][2][4][2], const Unit& u, int wr, int wc, int fr, int fq) const {
        const int row0 = u.pm * BM + wr * 64 + fr, col0 = u.pn * 256 + wc * 32 + 8 * fq;
        const float* gp = gate + (size_t)(u.pm >> 3) * 6144 + col0;
        f32x4 gq[2][2];
#pragma unroll
        for (int bj = 0; bj < 2; ++bj) { gq[bj][0] = *(const f32x4*)(gp + bj * HALF); gq[bj][1] = *(const f32x4*)(gp + bj * HALF + 4); }
#pragma unroll
        for (int bj = 0; bj < 2; ++bj) { const f32x4 g0 = gq[bj][0], g1 = gq[bj][1];
#pragma unroll
            for (int ai = 0; ai < 2; ++ai)
#pragma unroll
                for (int m = 0; m < 4; ++m) { const f32x4 v0 = acc[ai][bj][m][0] * g0, v1 = acc[ai][bj][m][1] * g1;
                    u32x4 w; w.x = cvt_pk_bf16(v0[0], v0[1]); w.y = cvt_pk_bf16(v0[2], v0[3]); w.z = cvt_pk_bf16(v1[0], v1[1]); w.w = cvt_pk_bf16(v1[2], v1[3]);
                    *(u32x4*)(out + (size_t)(row0 + ai * HALF + m * 16) * 1024 + col0 + bj * HALF) = w; } }
    }
};
struct EpiSwiglu {
    static constexpr bool PERM = true, AFTER_DRAIN = false;
    bf16_t* out;
    __device__ __forceinline__ void operator()(const f32x4 (&acc)[2][2][4][2], const Unit& u, int wr, int wc, int fr, int fq) const {
        const int row0 = u.pm * BM + wr * 64 + fr, col0 = u.pn * 128 + wc * 32 + 8 * fq;
#pragma unroll
        for (int ai = 0; ai < 2; ++ai)
#pragma unroll
            for (int m = 0; m < 4; ++m) { bf16_t* rowp = out + (size_t)(row0 + ai * HALF + m * 16) * 2816 + col0;
                const f32x4 g0 = acc[ai][0][m][0], g1 = acc[ai][0][m][1], u0 = acc[ai][1][m][0], u1 = acc[ai][1][m][1];
                u32x4 w;
                w.x = cvt_pk_bf16(g0[0] * sigm(g0[0]) * u0[0], g0[1] * sigm(g0[1]) * u0[1]);
                w.y = cvt_pk_bf16(g0[2] * sigm(g0[2]) * u0[2], g0[3] * sigm(g0[3]) * u0[3]);
                w.z = cvt_pk_bf16(g1[0] * sigm(g1[0]) * u1[0], g1[1] * sigm(g1[1]) * u1[1]);
                w.w = cvt_pk_bf16(g1[2] * sigm(g1[2]) * u1[2], g1[3] * sigm(g1[3]) * u1[3]);
                __builtin_nontemporal_store(w, (u32x4*)rowp); }
    }
};

template <class Epi, class Sched, bool ALIGN_EPI = false, bool SP2 = false>
__device__ __forceinline__ void gemm_phase(PG8_LAS unsigned char* lds, const Gemm g, const Sched& S, const Epi& E) {
    int tid_ = threadIdx.x; asm volatile("" : "+v"(tid_));
    const int tid = tid_, wid = __builtin_amdgcn_readfirstlane(tid >> 6), lane = tid & 63, wr = wid >> 2, wc = wid & 3, fr = lane & 15, fq = lane >> 4;
    const int K = g.K, nt = K / BK;
    unsigned voffA[2], voffB[2];
#pragma unroll
    for (int i = 0; i < 2; ++i) { int R, C; stage_rc(tid * 16 + i * 8192, R, C); const int Rb = Epi::PERM ? ((R & ~31) + perm32(R & 31)) : R;
        voffA[i] = (unsigned)(R * g.lda + C) * 2u; voffB[i] = (unsigned)(Rb * g.ldb + C) * 2u; }
    const size_t kstep = (size_t)(BK * 2);
    const size_t hstepA = (size_t)HALF * g.lda * 2, hstepB = (size_t)HALF * g.ldb * 2;
    const size_t tstepA = 2 * hstepA, tstepB = 2 * hstepB, apn = (size_t)g.apn;
    const unsigned ldsw = (unsigned)wid * 1024u;
    const int aoff = lds_byte(wr * 64 + fr, fq * 8), boff = lds_byte(wc * 32 + fr, fq * 8);
#define PG8_SA(b, h) (((b) * 2 + (h)) * HTB)
#define PG8_SB(b, h) ((4 + (b) * 2 + (h)) * HTB)
#define PG8_STAGE(bufoff, gbase, voff) do { _Pragma("unroll") for (int _i = 0; _i < 2; ++_i) \
        __builtin_amdgcn_global_load_lds((const unsigned*)((const char*)(gbase) + (voff)[_i]), (PG8_LAS unsigned*)(lds + (bufoff) + ldsw + _i * 8192), 16, 0, 0); } while (0)
#define PG8_LDA(dst, b, h) do { _Pragma("unroll") for (int m = 0; m < 4; ++m) _Pragma("unroll") for (int k = 0; k < 2; ++k) dst[m][k] = *(const PG8_LAS bf16x8*)(lds + PG8_SA(b, h) + aoff + m * 2048 + k * 1024); } while (0)
#define PG8_LDB(dst, b, h) do { _Pragma("unroll") for (int n = 0; n < 2; ++n) _Pragma("unroll") for (int k = 0; k < 2; ++k) dst[n][k] = *(const PG8_LAS bf16x8*)(lds + PG8_SB(b, h) + boff + n * 2048 + k * 1024); } while (0)
#define PG8_MMA(ai, bj, At, Bt) do { __builtin_amdgcn_s_setprio(1); _Pragma("unroll") for (int m = 0; m < 4; ++m) _Pragma("unroll") for (int n = 0; n < 2; ++n) _Pragma("unroll") for (int k = 0; k < 2; ++k) \
        acc[ai][bj][m][n] = __builtin_amdgcn_mfma_f32_16x16x32_bf16(Bt[n][k], At[m][k], acc[ai][bj][m][n], 0, 0, 0); __builtin_amdgcn_s_setprio(0); } while (0)
#define PG8_WAIT_V(n) asm volatile("s_waitcnt vmcnt(" #n ")" ::: "memory")
#define PG8_WAIT_L(n) asm volatile("s_waitcnt lgkmcnt(" #n ")" ::: "memory")
#define PG8_BAR __builtin_amdgcn_s_barrier()
#define PG8_SCHED __builtin_amdgcn_sched_barrier(0)
    Unit cur, nxt; int ui = 0;
    if (!S.next(0, cur)) return;
    f32x4 acc[2][2][4][2];
#pragma unroll
    for (int a = 0; a < 2; ++a)
#pragma unroll
        for (int b = 0; b < 2; ++b)
#pragma unroll
            for (int m = 0; m < 4; ++m)
#pragma unroll
                for (int n = 0; n < 2; ++n) acc[a][b][m][n] = (f32x4){0.f, 0.f, 0.f, 0.f};
    bf16x8 At[4][2], B0[2][2], B1[2][2];
    const char* cA = (const char*)g.A + (size_t)cur.pm * tstepA + (size_t)cur.pn * apn; const char* cB = (const char*)g.Bt + (size_t)cur.pn * tstepB;
    S.a_ready(cur);
    if constexpr (SP2) {
        PG8_STAGE(PG8_SB(0, 0), cB, voffB); PG8_STAGE(PG8_SB(0, 1), cB + hstepB, voffB); PG8_STAGE(PG8_SA(0, 0), cA, voffA); PG8_STAGE(PG8_SA(0, 1), cA + hstepA, voffA);
        if (wr == 1) PG8_BAR;
        PG8_WAIT_V(2); PG8_BAR;
        PG8_STAGE(PG8_SB(1, 0), cB + kstep, voffB); PG8_STAGE(PG8_SA(1, 0), cA + kstep, voffA); PG8_STAGE(PG8_SB(1, 1), cB + hstepB + kstep, voffB);
        PG8_WAIT_V(6); PG8_BAR;
    } else {
        PG8_STAGE(PG8_SB(0, 0), cB, voffB); PG8_STAGE(PG8_SA(0, 0), cA, voffA); PG8_STAGE(PG8_SB(0, 1), cB + hstepB, voffB); PG8_STAGE(PG8_SA(0, 1), cA + hstepA, voffA);
        if (wr == 1) PG8_BAR;
        PG8_WAIT_V(4); PG8_BAR;
        PG8_STAGE(PG8_SB(1, 0), cB + kstep, voffB); PG8_STAGE(PG8_SA(1, 0), cA + kstep, voffA); PG8_STAGE(PG8_SB(1, 1), cB + hstepB + kstep, voffB);
        PG8_WAIT_V(6); PG8_BAR;
    }
    for (;;) {
        const bool has_next = S.next(ui + 1, nxt);
        const char* nA = has_next ? (const char*)g.A + (size_t)nxt.pm * tstepA + (size_t)nxt.pn * apn : cA; const char* nB = has_next ? (const char*)g.Bt + (size_t)nxt.pn * tstepB : cB;
        for (int t = 0; t < nt; t += 2) {
            const bool last = (t == nt - 2);
            const char* a1 = cA + (size_t)(t + 1) * kstep;
            const char* a2 = last ? nA : cA + (size_t)(t + 2) * kstep; const char* b2 = last ? nB : cB + (size_t)(t + 2) * kstep;
            const char* a3 = a2 + kstep; const char* b3 = b2 + kstep;
            if (last && has_next) S.a_ready(nxt);
            if constexpr (SP2) {
            PG8_LDB(B0, 0, 0); PG8_LDB(B1, 0, 1); PG8_SCHED; PG8_LDA(At, 0, 0); PG8_STAGE(PG8_SA(1, 1), a1 + hstepA, voffA);
            PG8_WAIT_V(8); PG8_WAIT_L(0); PG8_BAR; PG8_MMA(0, 0, At, B0); PG8_MMA(0, 1, At, B1); PG8_BAR; PG8_SCHED;
            PG8_LDA(At, 0, 1); PG8_STAGE(PG8_SB(0, 0), b2, voffB); PG8_STAGE(PG8_SB(0, 1), b2 + hstepB, voffB); PG8_STAGE(PG8_SA(0, 0), a2, voffA);
            PG8_WAIT_V(8); PG8_WAIT_L(0); PG8_BAR; PG8_MMA(1, 0, At, B0); PG8_MMA(1, 1, At, B1); PG8_BAR; PG8_SCHED;
            PG8_LDB(B0, 1, 0); PG8_LDB(B1, 1, 1); PG8_SCHED; PG8_LDA(At, 1, 0); PG8_STAGE(PG8_SA(0, 1), a2 + hstepA, voffA);
            PG8_WAIT_V(8); PG8_WAIT_L(0); PG8_BAR; PG8_MMA(0, 0, At, B0); PG8_MMA(0, 1, At, B1); PG8_BAR; PG8_SCHED;
            PG8_LDA(At, 1, 1); PG8_STAGE(PG8_SB(1, 0), b3, voffB); PG8_STAGE(PG8_SB(1, 1), b3 + hstepB, voffB); PG8_STAGE(PG8_SA(1, 0), a3, voffA);
            PG8_WAIT_V(8); PG8_WAIT_L(0); PG8_BAR; PG8_MMA(1, 0, At, B0); PG8_MMA(1, 1, At, B1); PG8_BAR; PG8_SCHED;
            } else {
            PG8_LDB(B0, 0, 0); PG8_SCHED; PG8_LDA(At, 0, 0); PG8_STAGE(PG8_SA(1, 1), a1 + hstepA, voffA);
            PG8_WAIT_L(8); PG8_BAR; PG8_WAIT_L(0); PG8_MMA(0, 0, At, B0); PG8_BAR; PG8_SCHED;
            PG8_LDB(B1, 0, 1); PG8_STAGE(PG8_SB(0, 0), b2, voffB);
            PG8_BAR; PG8_WAIT_L(0); PG8_MMA(0, 1, At, B1); PG8_BAR;
            PG8_LDA(At, 0, 1); PG8_STAGE(PG8_SA(0, 0), a2, voffA);
            PG8_BAR; PG8_WAIT_L(0); PG8_MMA(1, 0, At, B0); PG8_BAR; PG8_SCHED;
            PG8_STAGE(PG8_SB(0, 1), b2 + hstepB, voffB);
            PG8_WAIT_V(6); PG8_BAR; PG8_MMA(1, 1, At, B1); PG8_BAR;
            PG8_LDB(B0, 1, 0); PG8_SCHED; PG8_LDA(At, 1, 0); PG8_STAGE(PG8_SA(0, 1), a2 + hstepA, voffA);
            PG8_WAIT_L(8); PG8_BAR; PG8_WAIT_L(0); PG8_MMA(0, 0, At, B0); PG8_BAR; PG8_SCHED;
            PG8_LDB(B1, 1, 1); PG8_STAGE(PG8_SB(1, 0), b3, voffB);
            PG8_BAR; PG8_WAIT_L(0); PG8_MMA(0, 1, At, B1); PG8_BAR;
            PG8_LDA(At, 1, 1); PG8_STAGE(PG8_SA(1, 0), a3, voffA);
            PG8_BAR; PG8_WAIT_L(0); PG8_MMA(1, 0, At, B0); PG8_BAR; PG8_SCHED;
            PG8_STAGE(PG8_SB(1, 1), b3 + hstepB, voffB);
            PG8_WAIT_V(6); PG8_BAR; PG8_MMA(1, 1, At, B1); PG8_BAR;
            }
        }
        if constexpr (ALIGN_EPI) { if (wr == 0) PG8_BAR; }
        if constexpr (!Epi::AFTER_DRAIN) { E(acc, cur, wr, wc, fr, fq); S.done(cur); }
        if (!has_next) break;
#pragma unroll
        for (int a = 0; a < 2; ++a)
#pragma unroll
            for (int b = 0; b < 2; ++b)
#pragma unroll
                for (int m = 0; m < 4; ++m)
#pragma unroll
                    for (int n = 0; n < 2; ++n) acc[a][b][m][n] = (f32x4){0.f, 0.f, 0.f, 0.f};
        cur = nxt; cA = nA; cB = nB; ++ui;
        if constexpr (ALIGN_EPI) { if (wr == 1) PG8_BAR; }
    }
    PG8_WAIT_V(0);
    if constexpr (!ALIGN_EPI) { if (wr == 0) PG8_BAR; }
    PG8_BAR;
    if constexpr (Epi::AFTER_DRAIN) { E.fused(acc, cur, wr, wc, fr, fq, lds, wid, lane); S.done(cur); }
#undef PG8_SA
#undef PG8_SB
#undef PG8_STAGE
#undef PG8_LDA
#undef PG8_LDB
#undef PG8_MMA
#undef PG8_WAIT_V
#undef PG8_WAIT_L
#undef PG8_BAR
#undef PG8_SCHED
}
}

namespace attn {
typedef unsigned short bf16_t;
using bf16x8 = __attribute__((ext_vector_type(8))) short;
using s16x4  = __attribute__((ext_vector_type(4))) short;
using f32x16 = __attribute__((ext_vector_type(16))) float;
using u32x4  = __attribute__((ext_vector_type(4))) unsigned;
constexpr int NW = 8, QBLK = 32, KVBLK = 64, LD = HEADMAJOR ? 128 : 1024;
constexpr size_t SHM_V = KVBLK * 128 * 2, SHM_K = KVBLK * 128 * 2, SHM_ATTN = 2 * SHM_V + 2 * SHM_K + NW * 64 * 4;
#ifndef ATT_REP
#define ATT_REP 1
#endif
constexpr float TSKIP = 40.f;
constexpr float THRL = 11.5f;
#define KSWZ(row, colB) ((row) * 256 + ((colB) ^ (((row) & 7) << 4)))
#define SBAR() __builtin_amdgcn_sched_barrier(0)
__device__ __forceinline__ int crow(int r, int hi) { return (r & 3) + 8 * (r >> 2) + 4 * hi; }
__device__ __forceinline__ unsigned cvtpk(float lo, float hi) { unsigned r; asm volatile("v_cvt_pk_bf16_f32 %0, %1, %2" : "=v"(r) : "v"(lo), "v"(hi)); return r; }
__device__ __forceinline__ bf16x8 ld8(const bf16_t* p) { return *reinterpret_cast<const bf16x8*>(p); }

__device__ __forceinline__ int v_st(int k, int c) { const int kk = (k & ~0xC) | ((k & 4) << 1) | ((k & 8) >> 1); return ((kk >> 3) * 4 + (c >> 5)) * 512 + ((kk & 7) * 32 + (c & 31)) * 2; }
__device__ __forceinline__ int v_rd_base(int lane) { return ((lane & 3) << 3) | (((lane >> 2) & 3) << 6) | (((lane >> 4) & 1) << 5) | (((lane >> 5) & 1) << 8); }
constexpr int v_rd_off(int d0, int ks, int half) { return d0 * 512 + ks * 4096 + half * 2048; }
template <int OFF> __device__ __forceinline__ s16x4 tr_read(int vb) {
  s16x4 r; asm volatile("ds_read_b64_tr_b16 %0, %1 offset:%2" : "=&v"(r) : "v"(vb), "i"(OFF) : "memory"); return r;
}
template <int D0> __device__ __forceinline__ void pv_one(f32x16& od, int vb, bf16x8 pa0, bf16x8 pa1, bf16x8 pa2, bf16x8 pa3) {
  const s16x4 l0 = tr_read<v_rd_off(D0, 0, 0)>(vb), h0 = tr_read<v_rd_off(D0, 0, 1)>(vb), l1 = tr_read<v_rd_off(D0, 1, 0)>(vb), h1 = tr_read<v_rd_off(D0, 1, 1)>(vb);
  const s16x4 l2 = tr_read<v_rd_off(D0, 2, 0)>(vb), h2 = tr_read<v_rd_off(D0, 2, 1)>(vb), l3 = tr_read<v_rd_off(D0, 3, 0)>(vb), h3 = tr_read<v_rd_off(D0, 3, 1)>(vb);
  asm volatile("s_waitcnt lgkmcnt(0)" ::: "memory"); SBAR();
#define PK(L, H) (bf16x8){L[0], L[1], L[2], L[3], H[0], H[1], H[2], H[3]}
  od = __builtin_amdgcn_mfma_f32_32x32x16_bf16(pa0, PK(l0, h0), od, 0, 0, 0);
  od = __builtin_amdgcn_mfma_f32_32x32x16_bf16(pa1, PK(l1, h1), od, 0, 0, 0);
  od = __builtin_amdgcn_mfma_f32_32x32x16_bf16(pa2, PK(l2, h2), od, 0, 0, 0);
  od = __builtin_amdgcn_mfma_f32_32x32x16_bf16(pa3, PK(l3, h3), od, 0, 0, 0);
#undef PK
}
__device__ __forceinline__ void pv_d0(f32x16* o, int vb, bf16x8 pa0, bf16x8 pa1, bf16x8 pa2, bf16x8 pa3) {
  pv_one<0>(o[0], vb, pa0, pa1, pa2, pa3); pv_one<1>(o[1], vb, pa0, pa1, pa2, pa3); pv_one<2>(o[2], vb, pa0, pa1, pa2, pa3); pv_one<3>(o[3], vb, pa0, pa1, pa2, pa3);
}

constexpr size_t SHM_X = 2 * SHM_V + 2 * SHM_K + NW * 64 * 4;
constexpr size_t SHM_ATTN_PP = SHM_X + 4 * 64 * 64 * 4;
__device__ __forceinline__ void qkt_c(f32x16& p0, f32x16& p1, const char* Ks, const bf16x8* qr, const f32x16& negm, int r32, int hi) {
#pragma unroll
  for (int d0 = 0; d0 < 4; ++d0) { const int cb = (d0 * 16 + hi * 8) * 2;
    bf16x8 b0 = *reinterpret_cast<const bf16x8*>(Ks + KSWZ(r32, cb));
    bf16x8 b1 = *reinterpret_cast<const bf16x8*>(Ks + KSWZ(32 + r32, cb));
    if (d0 == 0) { p0 = __builtin_amdgcn_mfma_f32_32x32x16_bf16(b0, qr[0], negm, 0, 0, 0); p1 = __builtin_amdgcn_mfma_f32_32x32x16_bf16(b1, qr[0], negm, 0, 0, 0); }
    else { p0 = __builtin_amdgcn_mfma_f32_32x32x16_bf16(b0, qr[d0], p0, 0, 0, 0); p1 = __builtin_amdgcn_mfma_f32_32x32x16_bf16(b1, qr[d0], p1, 0, 0, 0); } }
}
template <int R> __device__ __forceinline__ void bias_r(f32x16& p0, f32x16& p1, float dq, float nslope) {
  constexpr int C0 = (R & 3) + 8 * (R >> 2);
  float x0, x1, a0 = p0[R], a1 = p1[R];
  asm("v_sub_f32_e32 %0, %1, %2" : "=v"(x0) : "n"(__builtin_bit_cast(int, (float)C0)), "v"(dq));
  asm("v_sub_f32_e32 %0, %1, %2" : "=v"(x1) : "n"(__builtin_bit_cast(int, (float)(C0 + 32))), "v"(dq));
  asm("v_fma_f32 %0, %1, |%2|, %0" : "+v"(a0) : "v"(nslope), "v"(x0));
  asm("v_fma_f32 %0, %1, |%2|, %0" : "+v"(a1) : "v"(nslope), "v"(x1));
  p0[R] = a0; p1[R] = a1;
  if constexpr (R < 15) bias_r<R + 1>(p0, p1, dq, nslope);
}
__device__ __forceinline__ bool softmax_pp(f32x16& p0, f32x16& p1, float& m_reg, float& l_reg, f32x16& negm, float& alpha, float& m_run, float dq, float nslope,
                                           bf16x8& pa0, bf16x8& pa1, bf16x8& pa2, bf16x8& pa3) {
  bias_r<0>(p0, p1, dq, nslope);
  float a = fmaxf(fmaxf(p0[0], p0[1]), p1[0]), bq = fmaxf(fmaxf(p0[2], p0[3]), p1[1]); a = fmaxf(fmaxf(a, p1[2]), p1[3]);
#pragma unroll
  for (int r = 4; r < 16; r += 4) { a = fmaxf(fmaxf(a, p0[r]), p0[r + 1]); bq = fmaxf(fmaxf(bq, p0[r + 2]), p0[r + 3]); a = fmaxf(fmaxf(a, p1[r]), p1[r + 1]); bq = fmaxf(fmaxf(bq, p1[r + 2]), p1[r + 3]); }
  float pmax = fmaxf(a, bq);
  { auto rr = __builtin_amdgcn_permlane32_swap(__float_as_uint(pmax), __float_as_uint(pmax), false, false);
    pmax = fmaxf(__uint_as_float(rr[0]), __uint_as_float(rr[1])); }
  alpha = 1.f;
  { const float tmax = pmax + m_reg;
    if (__all(tmax < m_run - TSKIP)) return false;
    m_run = fmaxf(m_run, tmax); }
  if (__builtin_expect(!__all(pmax <= THRL), 0)) { const float dl = fmaxf(pmax, 0.f); m_reg += dl; alpha = __builtin_amdgcn_exp2f(-dl);
#pragma unroll
    for (int r = 0; r < 16; ++r) { p0[r] -= dl; p1[r] -= dl; }
#pragma unroll
    for (int r = 0; r < 16; ++r) negm[r] = -m_reg; }
#pragma unroll
  for (int r = 0; r < 16; ++r) { p0[r] = __builtin_amdgcn_exp2f(p0[r]); p1[r] = __builtin_amdgcn_exp2f(p1[r]); }
  float ps = 0;
#pragma unroll
  for (int r = 0; r < 16; ++r) ps += p0[r];
#pragma unroll
  for (int r = 0; r < 16; ++r) ps += p1[r];
  { auto rr = __builtin_amdgcn_permlane32_swap(__float_as_uint(ps), __float_as_uint(ps), false, false);
    ps = __uint_as_float(rr[0]) + __uint_as_float(rr[1]); }
  l_reg = l_reg * alpha + ps;
#define PK4(P, BASE, OUT) do { unsigned a0 = cvtpk(P[BASE + 0], P[BASE + 1]), a1 = cvtpk(P[BASE + 2], P[BASE + 3]);   \
    unsigned b0 = cvtpk(P[BASE + 4], P[BASE + 5]), b1 = cvtpk(P[BASE + 6], P[BASE + 7]);                              \
    auto r0 = __builtin_amdgcn_permlane32_swap(a0, b0, false, false); auto r1 = __builtin_amdgcn_permlane32_swap(a1, b1, false, false); \
    u32x4 w = {r0[0], r1[0], r0[1], r1[1]}; OUT = *reinterpret_cast<bf16x8*>(&w); } while (0)
  PK4(p0, 0, pa0); PK4(p0, 8, pa1); PK4(p1, 0, pa2); PK4(p1, 8, pa3);
#undef PK4
  return true;
}
__device__ __forceinline__ float sigm_(float x) { return __builtin_amdgcn_rcpf(1.0f + __builtin_amdgcn_exp2f(-1.4426950408889634f * x)); }
__device__ __forceinline__ void attn_unit_pp(int b, int h, int qb, int par, const bf16_t* __restrict__ QBp, const bf16_t* __restrict__ KBp, const bf16_t* __restrict__ VBp,
                                             const bf16_t* __restrict__ GBp, bf16_t* __restrict__ AOp, const bf16_t* __restrict__ PLDp, const bf16_t* __restrict__ WPLp, float lam, const float* __restrict__ sub_g, const unsigned* __restrict__ nrmk, char* lds) {
  int tid_ = threadIdx.x; asm volatile("" : "+v"(tid_));
  const int tid = tid_, wid = tid >> 6, lane = tid & 63, r32 = lane & 31, hi = lane >> 5, w4 = wid & 3, t256 = tid & 255;
  const int g = __builtin_amdgcn_readfirstlane(tid >> 8);
  const long rowbase = (long)b * SEQ; const int q0 = qb * 128;
  const size_t hoff = HEADMAJOR ? (size_t)(b * 8 + h) * SEQ * 128 : (size_t)b * SEQ * 1024 + h * 128;
  const bf16_t* Kh = KBp + hoff; const bf16_t* Vh = VBp + hoff;
  char* V_lds = lds; char* K_lds = lds + 2 * SHM_V;
  float* wsf = (float*)(lds + 2 * SHM_V + 2 * SHM_K) + wid * 64; float* li_l = wsf; float* al_l = wsf + 32;
  const float nslope = -exp2f(-(float)(h + 1)) * 1.4426950408889634f;
  const bf16_t* Qw = QBp + hoff + (size_t)(q0 + w4 * QBLK + r32) * LD + g * 64 + hi * 8;
  bf16x8 qr[4];
#pragma unroll
  for (int d0 = 0; d0 < 4; ++d0) qr[d0] = ld8(Qw + d0 * 16);
  const float qposf = (float)(q0 + w4 * QBLK + r32 - 4 * hi);
  const int sr = t256 >> 4, sc = (t256 & 15) * 8;
  int woff[4];
#pragma unroll
  for (int i = 0; i < 4; ++i) { const int row = sr + 16 * i; woff[i] = g ? (int)(2 * SHM_V) + KSWZ(row, sc * 2) : v_st(row, sc); }
  const bf16_t* Tsrc = (g ? Kh : Vh) + (long)sr * LD + sc;
  const char* Kmine = K_lds + g * 128;
  const int vb0 = (int)(uintptr_t)V_lds + v_rd_base(lane);
  float m_reg = 0.f, l_reg = 0.f, alpha = 1.f; f32x16 o[4]; f32x16 negm = f32x16{}; f32x16 p0, p1; bf16x8 pa0, pa1, pa2, pa3; bf16x8 stg[4];
#pragma unroll
  for (int d = 0; d < 4; ++d) o[d] = f32x16{};
  constexpr int NT = SEQ / KVBLK;
  float qn = 0.f;
#pragma unroll
  for (int d0 = 0; d0 < 4; ++d0) { const u32x4 w = __builtin_bit_cast(u32x4, qr[d0]);
#pragma unroll
    for (int e = 0; e < 4; ++e) { const float lo = __uint_as_float(w[e] << 16), hh = __uint_as_float(w[e] & 0xffff0000u); qn = fmaf(lo, lo, qn); qn = fmaf(hh, hh, qn); } }
  { auto rr = __builtin_amdgcn_permlane32_swap(__float_as_uint(qn), __float_as_uint(qn), false, false); qn = __uint_as_float(rr[0]) + __uint_as_float(rr[1]); }
  float sii = 0.f;
  { const bf16_t* Kw = Kh + (size_t)(q0 + w4 * QBLK + r32) * LD + g * 64 + hi * 8;
#pragma unroll
    for (int d0 = 0; d0 < 4; ++d0) { const u32x4 wq = __builtin_bit_cast(u32x4, qr[d0]); const u32x4 wk = __builtin_bit_cast(u32x4, ld8(Kw + d0 * 16));
#pragma unroll
      for (int e = 0; e < 4; ++e) { sii = fmaf(__uint_as_float(wq[e] << 16), __uint_as_float(wk[e] << 16), sii); sii = fmaf(__uint_as_float(wq[e] & 0xffff0000u), __uint_as_float(wk[e] & 0xffff0000u), sii); } } }
  { auto rr = __builtin_amdgcn_permlane32_swap(__float_as_uint(sii), __float_as_uint(sii), false, false); sii = __uint_as_float(rr[0]) + __uint_as_float(rr[1]); }
  { const unsigned* nk = nrmk + ((size_t)((b * 8 + h) * 2 + g)) * 2; const float kn = __uint_as_float(__hip_atomic_load(nk, __ATOMIC_RELAXED, __HIP_MEMORY_SCOPE_AGENT)) + __uint_as_float(__hip_atomic_load(nk + 1, __ATOMIC_RELAXED, __HIP_MEMORY_SCOPE_AGENT));
    qn = sqrtf(qn * kn) * 1.02f - sii; }
#pragma unroll
  for (int x = 1; x < 32; x <<= 1) qn = fmaxf(qn, __builtin_bit_cast(float, __builtin_amdgcn_ds_bpermute((lane ^ x) << 2, __builtin_bit_cast(int, qn))));
  float* xb = (float*)(lds + 143360 + 128) + par * 16;
  if (lane == 0) xb[wid] = qn;
  __syncthreads();
  float Bq = 0.f;
#pragma unroll
  for (int i = 0; i < 8; ++i) Bq = fmaxf(Bq, xb[i]);
  int jlo, n;
  { const float dmax = (TSKIP + Bq + 0.05f) / (-nslope);
    const float klo = (float)q0 - dmax, khi = (float)(q0 + 127) + dmax;
    int a0 = klo <= 0.f ? 0 : (int)(klo * (1.f / 64.f)); int a1 = khi >= (float)(SEQ - 1) ? NT - 1 : (int)(khi * (1.f / 64.f));
    if (((a1 - a0 + 1) & 1) != 0) { if (a0 > 0) --a0; else ++a1; }
    jlo = __builtin_amdgcn_readfirstlane(a0); n = __builtin_amdgcn_readfirstlane(a1 - a0 + 1); }
  const int dt = 2 * qb, nR = jlo + n - dt;
#define TILE(jj) ((jj) < nR ? dt + (jj) : dt - 1 - ((jj) - nR))
  float m_run = -1e30f; int live = 0;
#pragma unroll
  for (int i = 0; i < 4; ++i) stg[i] = ld8(Kh + (long)(TILE(g) * KVBLK + sr + 16 * i) * LD + sc);
#pragma unroll
  for (int i = 0; i < 4; ++i) *(bf16x8*)(K_lds + g * SHM_K + KSWZ(sr + 16 * i, sc * 2)) = stg[i];
  if (!g || n > 2) {
#pragma unroll
    for (int i = 0; i < 4; ++i) stg[i] = ld8(Tsrc + (long)(TILE(g ? 2 : 0) * KVBLK + 16 * i) * LD); }
  __syncthreads();
  if (g == 1) { __builtin_amdgcn_s_setprio(1); __syncthreads(); }
#define RESC_() do { if (__any(alpha < 1.f)) { if (hi == 0) al_l[r32] = alpha; asm volatile("s_waitcnt lgkmcnt(0)" ::: "memory"); \
    _Pragma("unroll") for (int d = 0; d < 4; ++d) _Pragma("unroll") for (int r = 0; r < 16; ++r) o[d][r] *= al_l[crow(r, hi)]; } } while (0)
#define PP_STEP(j, PAR) do { \
    qkt_c(p0, p1, Kmine + (PAR) * SHM_K, qr, negm, r32, hi); \
    if (live) pv_d0(o, vb0 + (1 - (PAR)) * (int)SHM_V, pa0, pa1, pa2, pa3); \
    __syncthreads(); \
    live = __builtin_amdgcn_readfirstlane((int)softmax_pp(p0, p1, m_reg, l_reg, negm, alpha, m_run, qposf - (float)(TILE(j) * KVBLK), nslope, pa0, pa1, pa2, pa3)); \
    RESC_(); \
    { const int wt = g ? (j) + 2 : (j); \
      if (wt < n) { _Pragma("unroll") for (int i = 0; i < 4; ++i) *(bf16x8*)(lds + woff[i] + (PAR) * 16384) = stg[i]; } \
      if (wt + 1 < n) { const int tn = TILE(wt + 1); _Pragma("unroll") for (int i = 0; i < 4; ++i) stg[i] = ld8(Tsrc + (long)(tn * KVBLK + 16 * i) * LD); } } \
    __syncthreads(); } while (0)
  _Pragma("nounroll") for (int j = 0; j < n; j += 2) { PP_STEP(j, 0); PP_STEP(j + 1, 1); }
  if (live) pv_d0(o, vb0 + (int)SHM_V, pa0, pa1, pa2, pa3);
  if (g == 0) __syncthreads();
#undef PP_STEP
#undef RESC_
#undef TILE
  if (hi == 0) li_l[r32] = l_reg; asm volatile("s_waitcnt lgkmcnt(0)" ::: "memory");
#pragma unroll
  for (int r = 0; r < 16; ++r) { const float rl = __builtin_amdgcn_rcpf(li_l[crow(r, hi)]);
#pragma unroll
    for (int d0 = 0; d0 < 4; ++d0) o[d0][r] *= rl; }
  float* xs = (float*)(lds + SHM_X) + w4 * 4096 + lane;
  const size_t row0 = (size_t)(rowbase + q0 + w4 * QBLK + 4 * hi);
  unsigned gofs = (unsigned)((row0 * 2048 + h * 128 + r32) * 2), aofs = (unsigned)((row0 * 1024 + h * 128 + r32) * 2);
  asm volatile("" : "+v"(gofs), "+v"(aofs));
#define GATE_LD(ro_, col_) (*(const unsigned short*)((const char*)GBp + (gofs + (unsigned)(((ro_) * 2048 + (col_)) * 2))))
#define MIX_ST(ro_, col_, v_) (*(unsigned short*)((char*)AOp + (aofs + (unsigned)(((ro_) * 1024 + (col_)) * 2))) = (v_))
  float* pgs = (float*)lds + w4 * 4096 + lane;
  if (g == 1) {
    unsigned gate16[64];
#pragma unroll
    for (int r = 0; r < 16; ++r)
#pragma unroll
      for (int d0 = 0; d0 < 4; ++d0) gate16[r * 4 + d0] = GATE_LD((r & 3) + 8 * (r >> 2), 1024 + d0 * 32);
    bf16x8 pf[8];
    { const bf16_t* pr = PLDp + (size_t)(rowbase + q0 + w4 * QBLK + r32) * 512 + (h >> 1) * 128 + hi * 8;
#pragma unroll
      for (int ks = 0; ks < 8; ++ks) pf[ks] = ld8(pr + ks * 16); }
#pragma unroll
    for (int d0 = 0; d0 < 4; ++d0)
#pragma unroll
      for (int r = 0; r < 16; ++r) xs[(d0 * 16 + r) * 64] = o[d0][r];
    __syncthreads();
    const bf16_t* wpb = WPLp + (size_t)((h >> 1) * 256 + (h & 1) * 128 + r32) * 128 + hi * 8;
#pragma unroll
    for (int dp = 0; dp < 2; ++dp) {
      bf16x8 wp[2][8];
#pragma unroll
      for (int e = 0; e < 2; ++e)
#pragma unroll
        for (int ks = 0; ks < 8; ++ks) wp[e][ks] = ld8(wpb + (dp * 2 + e) * 32 * 128 + ks * 16);
#pragma unroll
      for (int e = 0; e < 2; ++e) { const int d0 = dp * 2 + e; f32x16 acc = f32x16{};
#pragma unroll
        for (int ks = 0; ks < 8; ++ks) acc = __builtin_amdgcn_mfma_f32_32x32x16_bf16(pf[ks], wp[e][ks], acc, 0, 0, 0);
#pragma unroll
        for (int r = 0; r < 16; ++r) pgs[(d0 * 16 + r) * 64] = sigm_(__uint_as_float(gate16[r * 4 + d0] << 16)) * acc[r]; }
    }
    __syncthreads();
  } else {
    unsigned gate16[64];
#pragma unroll
    for (int r = 0; r < 16; ++r)
#pragma unroll
      for (int d0 = 0; d0 < 4; ++d0) gate16[r * 4 + d0] = GATE_LD((r & 3) + 8 * (r >> 2), d0 * 32);
    __syncthreads();
    float ss[16];
#pragma unroll
    for (int r = 0; r < 16; ++r) ss[r] = 0.f;
#pragma unroll
    for (int d0 = 0; d0 < 4; ++d0)
#pragma unroll
      for (int r = 0; r < 16; ++r) { const float v = o[d0][r] - lam * xs[(d0 * 16 + r) * 64]; o[d0][r] = v; ss[r] += v * v; }
#pragma unroll
    for (int r = 0; r < 16; ++r) { float s = ss[r];
#pragma unroll
      for (int x = 1; x < 32; x <<= 1) s += __builtin_bit_cast(float, __builtin_amdgcn_ds_bpermute((lane ^ x) << 2, __builtin_bit_cast(int, s)));
      ss[r] = 1.0f / sqrtf(s * (1.0f / 128.0f) + 1e-5f); }
    float sg[4];
#pragma unroll
    for (int d0 = 0; d0 < 4; ++d0) sg[d0] = sub_g[d0 * 32 + r32] * 0.8f;
#pragma unroll
    for (int r = 0; r < 16; ++r)
#pragma unroll
      for (int d0 = 0; d0 < 4; ++d0) { const float ga = __uint_as_float(gate16[r * 4 + d0] << 16); o[d0][r] = o[d0][r] * ss[r] * sg[d0] * sigm_(ga); }
    __syncthreads();
#pragma unroll
    for (int d0 = 0; d0 < 4; ++d0)
#pragma unroll
      for (int r = 0; r < 16; ++r) { const int ro = (r & 3) + 8 * (r >> 2);
        const float val = o[d0][r] + pgs[(d0 * 16 + r) * 64];
        unsigned u = __float_as_uint(val); u = (u + 0x7fffu + ((u >> 16) & 1u)) >> 16;
        MIX_ST(ro, d0 * 32, (unsigned short)u); }
  }
  __builtin_amdgcn_s_setprio(0);
#undef GATE_LD
#undef MIX_ST
}
#undef SBAR
}

#define GAS __attribute__((address_space(1)))
#define LAS __attribute__((address_space(3)))
typedef unsigned short bf16;
typedef unsigned v4u __attribute__((ext_vector_type(4)));
typedef float f32x4 __attribute__((ext_vector_type(4)));
constexpr int NWAVES = 8;
constexpr size_t MiB = 1u << 20;
constexpr size_t WS_MOD = 1 * MiB;
constexpr size_t WS_MODP = 2 * MiB;
constexpr size_t WS_WIN = 14 * MiB;
constexpr size_t WS_WOUT = 25 * MiB;
constexpr size_t WS_WF1 = 27 * MiB;
constexpr size_t WS_WF2 = 38 * MiB;
constexpr size_t WS_WPL = 44 * MiB;
constexpr size_t WS_H = 80 * MiB;
constexpr size_t WS_PLD = 208 * MiB;
constexpr size_t WS_Q = 272 * MiB, WS_K = 400 * MiB, WS_V = 528 * MiB, WS_U = 656 * MiB, WS_G = 720 * MiB;
constexpr size_t WS_ACT = 272 * MiB;
constexpr size_t WS_END = 976 * MiB;
constexpr int LDS_BYTES = 147456;

#define LDS_WAIT() asm volatile("s_waitcnt lgkmcnt(0)" ::: "memory")
__device__ __forceinline__ unsigned f2bf(float f) { unsigned u = __builtin_bit_cast(unsigned, f); return (u + 0x7fffu + ((u >> 16) & 1u)) >> 16; }
__device__ __forceinline__ unsigned pk2(float lo, float hi) { return f2bf(lo) | (f2bf(hi) << 16); }
__device__ __forceinline__ float wave_sum(float v, int lane) {
#pragma unroll
    for (int o = 1; o < 64; o <<= 1) v += __builtin_bit_cast(float, __builtin_amdgcn_ds_bpermute((lane ^ o) << 2, __builtin_bit_cast(int, v)));
    return v;
}
__device__ __forceinline__ void p0_transpose_item(const float* W, int K, int N, bf16* WT, int mode, LAS float* scr, int item, int lane, const float* nscale = nullptr) {
    const int nblk = N / 32, kb = item / nblk, nb = item % nblk, k0 = 64 * kb, n0 = 32 * nb;
    int d0 = n0;
    if (mode == 1) { d0 = (n0 < DFF) ? (256 * (n0 >> 7) + (n0 & 127)) : (256 * ((n0 - DFF) >> 7) + 128 + ((n0 - DFF) & 127)); }
    const float nsc = nscale ? nscale[n0 + (lane & 31)] : 1.0f;
    float wv[32];
#pragma unroll
    for (int i = 0; i < 32; ++i) { const int kk = 2 * i + (lane >> 5); wv[i] = __builtin_nontemporal_load(&W[(size_t)(k0 + kk) * N + n0 + (lane & 31)]); }
#pragma unroll
    for (int i = 0; i < 32; ++i) { const int kk = 2 * i + (lane >> 5); scr[kk * 33 + (lane & 31)] = wv[i] * nsc; }
    LDS_WAIT(); asm volatile("" ::: "memory");
    const int c = lane & 7;
#pragma unroll
    for (int j = 0; j < 4; ++j) { const int n = (lane >> 3) + 8 * j; const LAS float* s = scr + (8 * c) * 33 + n;
        v4u o; o.x = pk2(s[0 * 33], s[1 * 33]); o.y = pk2(s[2 * 33], s[3 * 33]); o.z = pk2(s[4 * 33], s[5 * 33]); o.w = pk2(s[6 * 33], s[7 * 33]);
        *(GAS v4u*)(WT + (size_t)(d0 + n) * K + k0 + 8 * c) = o; }
    LDS_WAIT(); asm volatile("" ::: "memory");
}
__device__ __forceinline__ void p0_mod_item(const float* c, const float* w_ada, float* part, LAS float* scr, int item, int lane) {
    const int cgp = item % 96, kc = item / 96, j = cgp * 64 + lane, k0 = kc * 64;
    { float cv[32];
#pragma unroll
      for (int b = 0; b < 32; ++b) cv[b] = c[b * 1024 + k0 + lane];
#pragma unroll
      for (int b = 0; b < 32; ++b) scr[b * 64 + lane] = cv[b] / (1.0f + __expf(-cv[b])); }
    LDS_WAIT(); asm volatile("" ::: "memory");
    float acc[32];
#pragma unroll
    for (int b = 0; b < 32; ++b) acc[b] = 0.f;
    for (int kk = 0; kk < 64; kk += 8) {
        float w[8];
#pragma unroll
        for (int i = 0; i < 8; ++i) w[i] = __builtin_nontemporal_load(&w_ada[(size_t)(k0 + kk + i) * NMOD + j]);
#pragma unroll
        for (int b = 0; b < 32; ++b) { const f32x4 s0 = *(const LAS f32x4*)(scr + b * 64 + kk), s1 = *(const LAS f32x4*)(scr + b * 64 + kk + 4);
            acc[b] += (s0.x * w[0] + s0.y * w[1] + s0.z * w[2] + s0.w * w[3]) + (s1.x * w[4] + s1.y * w[5] + s1.z * w[6] + s1.w * w[7]); }
    }
#pragma unroll
    for (int b = 0; b < 32; ++b) part[(size_t)(kc * 32 + b) * NMOD + j] = acc[b];
    LDS_WAIT(); asm volatile("" ::: "memory");
}

#define XB_TMO      128
#define XB_XCNT(j)  (256  + 64 * (j))
#define XB_XSUB(j)  (1280 + 64 * (j))
#define XB_XGEN(j)  (2304 + 64 * (j))
#define XB_TOP      3328
#define XB_TOPGEN   3392
#define XCD_BAR_WORDS 3456
#define XB_SPIN_CAP (1u << 18)

__device__ __forceinline__ unsigned xb_ld(unsigned* p)              { return __hip_atomic_load(p, __ATOMIC_RELAXED, __HIP_MEMORY_SCOPE_AGENT); }
__device__ __forceinline__ unsigned xb_add(unsigned* p, unsigned v) { return __hip_atomic_fetch_add(p, v, __ATOMIC_RELAXED, __HIP_MEMORY_SCOPE_AGENT); }
__device__ __forceinline__ unsigned xb_xcc_id() { return (unsigned)__builtin_amdgcn_s_getreg((3 << 11) | 20) & 0xFu; }
#define XB_SPIN(cond, bar) do { unsigned _sp = 0; while (cond) { __builtin_amdgcn_s_sleep(1); \
    if ((++_sp & 255u) == 0u) { if (xb_ld(&(bar)[XB_TMO])) break; if (_sp > XB_SPIN_CAP) { atomicAdd(&(bar)[XB_TMO], 1u); break; } } } } while (0)

struct XcdBarrier {
    unsigned* bar; unsigned x;
    volatile LAS unsigned* st;
};

__device__ __forceinline__ XcdBarrier xcd_barrier_post(unsigned* bar, volatile LAS unsigned* st) {
    XcdBarrier b; b.bar = bar; b.x = xb_xcc_id(); b.st = st;
    if (threadIdx.x == 0) (void)xb_add(&bar[XB_XCNT(b.x)], 1u);
    return b;
}
__device__ __forceinline__ void xcd_barrier_complete(unsigned* bar, unsigned x, unsigned& nloc, unsigned& nx) {
    const unsigned G = gridDim.x * gridDim.y * gridDim.z;
    unsigned sum, cnt, mine, sp = 0u;
    for (;;) {
        sum = 0u; cnt = 0u; mine = 0u;
#pragma unroll
        for (unsigned j = 0; j < 16; ++j) { const unsigned c = xb_ld(&bar[XB_XCNT(j)]); sum += c; cnt += (c > 0u) ? 1u : 0u; mine = (j == x) ? c : mine; }
        if (sum == G) break;
        __builtin_amdgcn_s_sleep(1);
        if ((++sp & 255u) == 0u) { if (xb_ld(&bar[XB_TMO])) break; if (sp > XB_SPIN_CAP) { atomicAdd(&bar[XB_TMO], 1u); break; } }
    }
    nloc = mine > 0u ? mine : 1u; nx = cnt > 0u ? cnt : 1u;
}

__device__ __forceinline__ void xcd_barrier(const XcdBarrier& b) {
    asm volatile("s_waitcnt vmcnt(0)" ::: "memory");
    __syncthreads();
    if (threadIdx.x == 0) {
        unsigned* bar = b.bar;
        __builtin_amdgcn_s_waitcnt(0);
        unsigned nloc = b.st[0], nx = b.st[1];
        if (nloc == 0u) { xcd_barrier_complete(bar, b.x, nloc, nx); b.st[0] = nloc; b.st[1] = nx; }
        const unsigned old = xb_add(&bar[XB_XSUB(b.x)], 1u);
        const unsigned gen = old / nloc;
        if (old + 1u == (gen + 1u) * nloc) {
            __builtin_amdgcn_fence(__ATOMIC_RELEASE, "agent");
            asm volatile("s_waitcnt vmcnt(0)" ::: "memory");
            const unsigned og = xb_add(&bar[XB_TOP], 1u);
            const unsigned tg = og / nx;
            if (og + 1u == (tg + 1u) * nx) xb_add(&bar[XB_TOPGEN], 1u);
            else XB_SPIN(xb_ld(&bar[XB_TOPGEN]) == tg, bar);
            __builtin_amdgcn_fence(__ATOMIC_ACQUIRE, "agent");
            xb_add(&bar[XB_XGEN(b.x)], 1u);
            asm volatile("s_waitcnt vmcnt(0)" ::: "memory");
        } else {
            XB_SPIN(xb_ld(&bar[XB_XGEN(b.x)]) == gen, bar);
            __builtin_amdgcn_fence(__ATOMIC_ACQUIRE, "agent");
            asm volatile("s_waitcnt vmcnt(0)" ::: "memory");
        }
    }
    __syncthreads();
}

struct Args { const float* in[19]; float* out; unsigned char* ws; };
#define PHASE_IDS int t__ = threadIdx.x; asm volatile("" : "+v"(t__)); const int tid = t__, lane = tid & 63, wave = __builtin_amdgcn_readfirstlane(tid >> 6), gw = vcu * NWAVES + wave; (void)tid; (void)lane; (void)wave; (void)gw

__global__ void __launch_bounds__(NWAVES * 64) mega_fwd(Args args) {
    extern __shared__ __attribute__((aligned(16))) unsigned char lds[];
    cg::grid_group grid = cg::this_grid();
    const int tid = threadIdx.x, lane = tid & 63, wave = __builtin_amdgcn_readfirstlane(tid >> 6);
    const int G = gridDim.x, bx = blockIdx.x; int vcu = bx, gc = bx;
    const int NGW = G * NWAVES;
    unsigned char* ws = args.ws;
    unsigned* ctl = (unsigned*)ws;
    volatile LAS unsigned* misc = (volatile LAS unsigned*)((LAS unsigned char*)lds + 143360);
    if (tid < 16) misc[tid] = 0u;
    __syncthreads();
    const XcdBarrier xbar = xcd_barrier_post((unsigned*)(ws + 16384), misc + 8);
    if (tid == 0) { const unsigned xcc = (unsigned)__builtin_amdgcn_s_getreg((3 << 11) | 20) & 0xFu;
        misc[0] = xcc; misc[1] = __hip_atomic_fetch_add(ctl + 64 * xcc, 1u, __ATOMIC_RELAXED, __HIP_MEMORY_SCOPE_AGENT); }
    const float* x = args.in[0]; const float* cvec = args.in[1]; const float* w_ada = args.in[2]; const float* b_ada = args.in[3]; const float* w_in = args.in[4];
    const float* lq1 = args.in[5]; const float* lk1 = args.in[6]; const float* lq2 = args.in[7]; const float* lk2 = args.in[8]; const float* sub_g = args.in[9];
    const float* w_pool = args.in[10]; const float* pool_scale = args.in[11]; const float* w_out = args.in[12]; const float* ln1_g = args.in[13]; const float* ln1_b = args.in[14];
    const float* w_f1 = args.in[15]; const float* w_f2 = args.in[16]; const float* ln2_g = args.in[17]; const float* ln2_b = args.in[18];
    float* out = args.out;
    float* MOD = (float*)(ws + WS_MOD); float* MODP = (float*)(ws + WS_MODP);
    bf16* Wt_in = (bf16*)(ws + WS_WIN); bf16* Wt_out = (bf16*)(ws + WS_WOUT); bf16* Wt_f1 = (bf16*)(ws + WS_WF1); bf16* Wt_f2 = (bf16*)(ws + WS_WF2); bf16* Wt_pl = (bf16*)(ws + WS_WPL);
    bf16* HB = (bf16*)(ws + WS_H); bf16* PLD = (bf16*)(ws + WS_PLD);
    bf16* QB = (bf16*)(ws + WS_Q); bf16* KB = (bf16*)(ws + WS_K); bf16* VB = (bf16*)(ws + WS_V); bf16* UB = (bf16*)(ws + WS_U); bf16* GB = (bf16*)(ws + WS_G);
    bf16* ACT = (bf16*)(ws + WS_ACT);
    bf16* Y1 = (bf16*)(ws + WS_Q); bf16* Y2 = (bf16*)(ws + WS_G);
    unsigned* NRMK = (unsigned*)(ws + 8192);

    {
        PHASE_IDS;
        LAS float* scr = (LAS float*)((LAS unsigned char*)lds + wave * 16384);
        constexpr int I_IN = 16 * 176, I_OUT = 16 * 32, I_F1 = 16 * 176, I_F2 = 44 * 32, I_PL = 64, I_MOD = 96 * 16;
        constexpr int NITEMS = I_IN + I_OUT + I_F1 + I_F2 + I_PL + I_MOD;
        for (int it = gw; it < NITEMS; it += NGW) {
            int r = it;
            if (r < I_MOD) { p0_mod_item(cvec, w_ada, MODP, scr, r, lane); continue; } r -= I_MOD;
            if (r < I_IN) { p0_transpose_item(w_in, D, INC, Wt_in, 0, scr, r, lane); continue; } r -= I_IN;
            if (r < I_OUT) { p0_transpose_item(w_out, D, D, Wt_out, 0, scr, r, lane); continue; } r -= I_OUT;
            if (r < I_F1) { p0_transpose_item(w_f1, D, 2 * DFF, Wt_f1, 1, scr, r, lane); continue; } r -= I_F1;
            if (r < I_F2) { p0_transpose_item(w_f2, DFF, D, Wt_f2, 0, scr, r, lane); continue; } r -= I_F2;
            { const int g = r >> 4; p0_transpose_item(w_pool + (size_t)g * 128 * 256, 128, 256, Wt_pl + (size_t)g * 256 * 128, 0, scr, r & 15, lane, pool_scale + g * 256); }
        }
    }
    if (gridDim.y > 1) grid.sync();
    xcd_barrier(xbar);
    {
        if (threadIdx.x < 64) {
            const unsigned l_ = threadIdx.x, cj = l_ < 16u ? __hip_atomic_load(ctl + 64 * l_, __ATOMIC_RELAXED, __HIP_MEMORY_SCOPE_AGENT) : 0u;
            const unsigned xcc = misc[0], rank = misc[1]; unsigned pre = 0; bool even8 = true;
#pragma unroll
            for (int j = 0; j < 16; ++j) { const unsigned c_ = (unsigned)__builtin_amdgcn_readlane((int)cj, j);
                if ((unsigned)j < xcc) pre += c_; if (j < 8 ? (c_ * 8u != (unsigned)G) : (c_ != 0u)) even8 = false; }
            if (l_ == 0) { misc[2] = pre + rank; misc[3] = even8 ? rank * 8u + xcc : (unsigned)bx; } }
        __syncthreads();
        vcu = (int)misc[2]; gc = (int)misc[3];
        vcu = __builtin_amdgcn_readfirstlane(vcu); gc = __builtin_amdgcn_readfirstlane(gc);
    }

    {
        PHASE_IDS;
        LAS float* shsc = (LAS float*)lds;
        for (int p = vcu; p < MROWS / 256; p += G) {
            const int b = p >> 3, k8 = p & 7;
            __syncthreads();
            { float sv[5];
#pragma unroll
              for (int i = 0; i < 5; ++i) { const int j = tid + i * NWAVES * 64; const int col = j < 2048 ? j : 2048 + 512 * k8 + (j - 2048); float s = b_ada[col];
#pragma unroll
                  for (int kc = 0; kc < 16; ++kc) s += MODP[(size_t)(kc * 32 + b) * NMOD + col];
                  sv[i] = s; }
#pragma unroll
              for (int i = 0; i < 5; ++i) { const int j = tid + i * NWAVES * 64; const int col = j < 2048 ? j : 2048 + 512 * k8 + (j - 2048);
                  if (j < 2048) shsc[j] = sv[i]; else MOD[(size_t)b * NMOD + col] = sv[i]; } }
            __syncthreads();
            for (int rr = wave; rr < 256; rr += NWAVES) {
                const size_t row = (size_t)p * 256 + rr;
                const GAS f32x4* xr = (const GAS f32x4*)(x + row * D) + lane;
                f32x4 v[4]; float s = 0.f;
#pragma unroll
                for (int j = 0; j < 4; ++j) { v[j] = __builtin_nontemporal_load(&xr[64 * j]); s += (v[j].x + v[j].y) + (v[j].z + v[j].w); }
                const float mean = wave_sum(s, lane) * (1.f / D); float s2 = 0.f;
#pragma unroll
                for (int j = 0; j < 4; ++j) { v[j] = v[j] - mean; s2 += (v[j].x * v[j].x + v[j].y * v[j].y) + (v[j].z * v[j].z + v[j].w * v[j].w); }
                const float rstd = 1.f / sqrtf(wave_sum(s2, lane) * (1.f / D) + LN_EPS);
                GAS unsigned long long* o8 = (GAS unsigned long long*)(HB + row * D) + lane;
#pragma unroll
                for (int j = 0; j < 4; ++j) { const f32x4 sh = *(const LAS f32x4*)(shsc + 256 * j + 4 * lane), sc = *(const LAS f32x4*)(shsc + 1024 + 256 * j + 4 * lane);
                    const f32x4 y = v[j] * rstd * (sc + 1.0f) + sh;
                    o8[64 * j] = (unsigned long long)pk2(y.x, y.y) | ((unsigned long long)pk2(y.z, y.w) << 32); }
            }
        }
    }
    xcd_barrier(xbar);

    {
        PHASE_IDS;
        pg8::Gemm g{HB, Wt_in, MROWS, INC, D, D, D, 0}; pg8::StaticOrder S; S.init(MROWS, INC, G, gc);
        pg8::EpiProj E{QB, KB, VB, UB, GB, QSCALE, NRMK};
        pg8::gemm_phase<pg8::EpiProj, pg8::StaticOrder, true, true>((LAS unsigned char*)lds, g, S, E);
    }
    xcd_barrier(xbar);

    {
        PHASE_IDS;
        for (int chunk = gw; chunk < MROWS / 32; chunk += NGW) {
            const int row0 = chunk * 32, t0 = row0 & (SEQ - 1), gi = lane >> 4, half = 1 << gi;
            const bf16* base = UB + (size_t)(row0 - t0) * PIN + lane * 8;
            float s[8];
#pragma unroll
            for (int e = 0; e < 8; ++e) s[e] = 0.f;
#define ACC_ROW(tau, sgn) do { const v4u w_ = *(const v4u*)(base + (size_t)(tau) * PIN); \
                s[0] += (sgn) * pg8::bf_lo(w_.x); s[1] += (sgn) * pg8::bf_hi(w_.x); s[2] += (sgn) * pg8::bf_lo(w_.y); s[3] += (sgn) * pg8::bf_hi(w_.y); \
                s[4] += (sgn) * pg8::bf_lo(w_.z); s[5] += (sgn) * pg8::bf_hi(w_.z); s[6] += (sgn) * pg8::bf_lo(w_.w); s[7] += (sgn) * pg8::bf_hi(w_.w); } while (0)
            { const int lo = (t0 - half) > 0 ? (t0 - half) : 0, hi = (t0 + half) < SEQ ? (t0 + half) : SEQ;
              v4u w16[16];
#pragma unroll
              for (int q = 0; q < 16; ++q) w16[q] = *(const v4u*)(base + (size_t)((lo + q) < hi ? (lo + q) : lo) * PIN);
#pragma unroll
              for (int q = 0; q < 16; ++q) { const float m_ = (lo + q) < hi ? 1.0f : 0.0f; const v4u a_ = w16[q];
                  s[0] += m_ * pg8::bf_lo(a_.x); s[1] += m_ * pg8::bf_hi(a_.x); s[2] += m_ * pg8::bf_lo(a_.y); s[3] += m_ * pg8::bf_hi(a_.y);
                  s[4] += m_ * pg8::bf_lo(a_.z); s[5] += m_ * pg8::bf_hi(a_.z); s[6] += m_ * pg8::bf_lo(a_.w); s[7] += m_ * pg8::bf_hi(a_.w); } }
            for (int tt = 0; tt < 32; tt += 4) {
                v4u ut[4], wa[4], wr[4]; float ma[4], mr[4];
#pragma unroll
                for (int q = 0; q < 4; ++q) { const int t = t0 + tt + q, ta = t + half, tr = t - half;
                    ut[q] = *(const v4u*)(base + (size_t)t * PIN);
                    ma[q] = ta < SEQ ? 1.0f : 0.0f; wa[q] = *(const v4u*)(base + (size_t)(ta < SEQ ? ta : SEQ - 1) * PIN);
                    mr[q] = tr >= 0 ? -1.0f : 0.0f; wr[q] = *(const v4u*)(base + (size_t)(tr >= 0 ? tr : 0) * PIN); }
#pragma unroll
                for (int q = 0; q < 4; ++q) { const int t = t0 + tt + q, lo = (t - half) > 0 ? (t - half) : 0, hi = (t + half) < SEQ ? (t + half) : SEQ;
                    const float inv = 1.0f / (float)(hi - lo); const v4u u_ = ut[q];
                    v4u o; o.x = pk2(s[0] * inv - pg8::bf_lo(u_.x), s[1] * inv - pg8::bf_hi(u_.x)); o.y = pk2(s[2] * inv - pg8::bf_lo(u_.y), s[3] * inv - pg8::bf_hi(u_.y));
                    o.z = pk2(s[4] * inv - pg8::bf_lo(u_.z), s[5] * inv - pg8::bf_hi(u_.z)); o.w = pk2(s[6] * inv - pg8::bf_lo(u_.w), s[7] * inv - pg8::bf_hi(u_.w));
                    *(v4u*)(PLD + (size_t)(row0 + tt + q) * PIN + lane * 8) = o;
                    { const v4u a_ = wa[q]; const float m_ = ma[q];
                      s[0] += m_ * pg8::bf_lo(a_.x); s[1] += m_ * pg8::bf_hi(a_.x); s[2] += m_ * pg8::bf_lo(a_.y); s[3] += m_ * pg8::bf_hi(a_.y);
                      s[4] += m_ * pg8::bf_lo(a_.z); s[5] += m_ * pg8::bf_hi(a_.z); s[6] += m_ * pg8::bf_lo(a_.w); s[7] += m_ * pg8::bf_hi(a_.w); }
                    { const v4u r_ = wr[q]; const float m_ = mr[q];
                      s[0] += m_ * pg8::bf_lo(r_.x); s[1] += m_ * pg8::bf_hi(r_.x); s[2] += m_ * pg8::bf_lo(r_.y); s[3] += m_ * pg8::bf_hi(r_.y);
                      s[4] += m_ * pg8::bf_lo(r_.z); s[5] += m_ * pg8::bf_hi(r_.z); s[6] += m_ * pg8::bf_lo(r_.w); s[7] += m_ * pg8::bf_hi(r_.w); } }
            }
#undef ACC_ROW
        }
        xcd_barrier(xbar);
        const float lam = __expf(wave_sum(lq1[lane] * lk1[lane], lane)) - __expf(wave_sum(lq2[lane] * lk2[lane], lane)) + 0.2f;
        for (int i = 0, U = vcu; U < BATCH * NH * (SEQ / 128); U += G, ++i) {
            int b = U >> 7, h = (U >> 4) & 7, qb = U & 15;
            if (G == 256) { const int gi = vcu >> 4; h = (gi + i) & 7; b = i * 2 + (gi >> 3); qb = (vcu + i) & 15; }
            attn::attn_unit_pp(b, h, qb, i & 1, QB, KB, VB, GB, HB, PLD, Wt_pl, lam, sub_g, NRMK, (char*)lds);
        }
        __syncthreads();
    }
    xcd_barrier(xbar);

    {
        PHASE_IDS;
        pg8::Gemm g{HB, Wt_out, MROWS, D, D, D, D, 0}; pg8::StaticOrder S; S.init(MROWS, D, G, gc);
        pg8::EpiGate E{Y1, MOD + 2048};
        pg8::gemm_phase<pg8::EpiGate, pg8::StaticOrder, true, true>((LAS unsigned char*)lds, g, S, E);
    }
    xcd_barrier(xbar);

    {
        PHASE_IDS;
        f32x4 g1v[4], b1v[4];
#pragma unroll
        for (int j = 0; j < 4; ++j) { g1v[j] = *(const f32x4*)(ln1_g + 256 * j + 4 * lane); b1v[j] = *(const f32x4*)(ln1_b + 256 * j + 4 * lane); }
    for (int row = gw; row < MROWS; row += NGW) {
        const int b = row >> 11; const float* mb = MOD + (size_t)b * NMOD;
        GAS f32x4* zr = (GAS f32x4*)(out + (size_t)row * D) + lane;
        const GAS f32x4* xr = (const GAS f32x4*)(x + (size_t)row * D) + lane;
        const GAS unsigned long long* yr = (const GAS unsigned long long*)(Y1 + (size_t)row * D) + lane;
        f32x4 v[4]; float s = 0.f;
#pragma unroll
        for (int j = 0; j < 4; ++j) { const f32x4 xv = __builtin_nontemporal_load(&xr[64 * j]); const unsigned long long yy = __builtin_nontemporal_load(&yr[64 * j]); const unsigned ylo = (unsigned)yy, yhi = (unsigned)(yy >> 32);
            v[j] = xv * ALPHA + (f32x4){pg8::bf_lo(ylo), pg8::bf_hi(ylo), pg8::bf_lo(yhi), pg8::bf_hi(yhi)};
            s += (v[j].x + v[j].y) + (v[j].z + v[j].w); }
        float mean = wave_sum(s, lane) * (1.f / D), s2 = 0.f;
#pragma unroll
        for (int j = 0; j < 4; ++j) { v[j] = v[j] - mean; s2 += (v[j].x * v[j].x + v[j].y * v[j].y) + (v[j].z * v[j].z + v[j].w * v[j].w); }
        float rstd = 1.f / sqrtf(wave_sum(s2, lane) * (1.f / D) + LN_EPS);
        s = 0.f;
#pragma unroll
        for (int j = 0; j < 4; ++j) { const f32x4 gg = g1v[j], bb = b1v[j];
            v[j] = v[j] * rstd * gg + bb; __builtin_nontemporal_store(v[j], &zr[64 * j]); s += (v[j].x + v[j].y) + (v[j].z + v[j].w); }
        mean = wave_sum(s, lane) * (1.f / D); s2 = 0.f;
#pragma unroll
        for (int j = 0; j < 4; ++j) { v[j] = v[j] - mean; s2 += (v[j].x * v[j].x + v[j].y * v[j].y) + (v[j].z * v[j].z + v[j].w * v[j].w); }
        rstd = 1.f / sqrtf(wave_sum(s2, lane) * (1.f / D) + LN_EPS);
        GAS unsigned long long* o8 = (GAS unsigned long long*)(HB + (size_t)row * D) + lane;
#pragma unroll
        for (int j = 0; j < 4; ++j) { const f32x4 sh = *(const f32x4*)(mb + 3072 + 256 * j + 4 * lane), sc = *(const f32x4*)(mb + 4096 + 256 * j + 4 * lane);
            const f32x4 y = v[j] * rstd * (sc + 1.0f) + sh;
            o8[64 * j] = (unsigned long long)pk2(y.x, y.y) | ((unsigned long long)pk2(y.z, y.w) << 32); }
    }
    }
    xcd_barrier(xbar);

    {
        PHASE_IDS;
        pg8::Gemm g{HB, Wt_f1, MROWS, 2 * DFF, D, D, D, 0}; pg8::StaticOrder S; S.init(MROWS, 2 * DFF, G, gc);
        pg8::EpiSwiglu E{ACT};
        pg8::gemm_phase<pg8::EpiSwiglu, pg8::StaticOrder, true, true>((LAS unsigned char*)lds, g, S, E);
    }
    xcd_barrier(xbar);

    {
        PHASE_IDS;
        pg8::Gemm g{ACT, Wt_f2, MROWS, D, DFF, DFF, DFF, 0}; pg8::StaticOrder S; S.init(MROWS, D, G, gc);
        pg8::EpiGate E{Y2, MOD + 5120};
        pg8::gemm_phase<pg8::EpiGate, pg8::StaticOrder, true, true>((LAS unsigned char*)lds, g, S, E);
    }
    xcd_barrier(xbar);

    {
        PHASE_IDS;
        f32x4 g2v[4], b2v[4];
#pragma unroll
        for (int jj = 0; jj < 4; ++jj) { g2v[jj] = *(const f32x4*)(ln2_g + 256 * jj + 4 * lane); b2v[jj] = *(const f32x4*)(ln2_b + 256 * jj + 4 * lane); }
    for (int row = gw; row < MROWS; row += NGW) {
        GAS f32x4* zr = (GAS f32x4*)(out + (size_t)row * D) + lane;
        const GAS unsigned long long* yr = (const GAS unsigned long long*)(Y2 + (size_t)row * D) + lane;
        f32x4 v[4]; float s = 0.f;
#pragma unroll
        for (int j = 0; j < 4; ++j) { const f32x4 xv = __builtin_nontemporal_load(&zr[64 * j]); const unsigned long long yy = __builtin_nontemporal_load(&yr[64 * j]); const unsigned ylo = (unsigned)yy, yhi = (unsigned)(yy >> 32);
            v[j] = xv * ALPHA + (f32x4){pg8::bf_lo(ylo), pg8::bf_hi(ylo), pg8::bf_lo(yhi), pg8::bf_hi(yhi)};
            s += (v[j].x + v[j].y) + (v[j].z + v[j].w); }
        const float mean = wave_sum(s, lane) * (1.f / D); float s2 = 0.f;
#pragma unroll
        for (int j = 0; j < 4; ++j) { v[j] = v[j] - mean; s2 += (v[j].x * v[j].x + v[j].y * v[j].y) + (v[j].z * v[j].z + v[j].w * v[j].w); }
        const float rstd = 1.f / sqrtf(wave_sum(s2, lane) * (1.f / D) + LN_EPS);
#pragma unroll
        for (int j = 0; j < 4; ++j) { const f32x4 gg = g2v[j], bb = b2v[j];
            __builtin_nontemporal_store(v[j] * rstd * gg + bb, &zr[64 * j]); }
    }
    }
}

extern "C" void kernel_launch(void* const* d_in, const int* in_sizes, int n_in, void* d_out, int out_size, void* d_ws, size_t ws_size, hipStream_t stream) {
    static int grid = 0;
    if (grid == 0) {
        if (n_in != 19 || in_sizes[0] != MROWS * D || out_size != MROWS * D || ws_size < WS_END) {
            fprintf(stderr, "kernel_launch: shape mismatch: n_in %d in0 %d out %d ws %zu (need >= %zu)\n", n_in, n_in > 0 ? in_sizes[0] : -1, out_size, ws_size, (size_t)WS_END); grid = -1; return; }
        int dev = 0, cus = 0, per_cu = 0;
        if (hipGetDevice(&dev) != hipSuccess || hipDeviceGetAttribute(&cus, hipDeviceAttributeMultiprocessorCount, dev) != hipSuccess) { grid = -1; return; }
        if (hipFuncSetAttribute((const void*)mega_fwd, hipFuncAttributeMaxDynamicSharedMemorySize, LDS_BYTES) != hipSuccess) { fprintf(stderr, "kernel_launch: hipFuncSetAttribute failed\n"); grid = -1; return; }
        if (hipOccupancyMaxActiveBlocksPerMultiprocessor(&per_cu, (const void*)mega_fwd, NWAVES * 64, LDS_BYTES) != hipSuccess || per_cu < 1) { fprintf(stderr, "kernel_launch: occupancy query gave %d\n", per_cu); per_cu = 1; }
        (void)hipGetLastError();
        grid = cus * per_cu; if (grid > 256) grid = 256;
    }
    if (grid < 0) return;
    if (hipMemsetAsync(d_ws, 0, 32768, stream) != hipSuccess) { fprintf(stderr, "kernel_launch: memset failed\n"); return; }
    Args a{};
    for (int i = 0; i < 19; ++i) a.in[i] = (const float*)d_in[i];
    a.out = (float*)d_out; a.ws = (unsigned char*)d_ws;
    void* kargs[] = {&a};
    const hipError_t e = hipLaunchCooperativeKernel((const void*)mega_fwd, dim3(grid), dim3(NWAVES * 64), kargs, LDS_BYTES, stream);
    if (e != hipSuccess) fprintf(stderr, "kernel_launch: cooperative launch failed: %s (grid %d)\n", hipGetErrorString(e), grid);
}
```
